# Optimizing an MI355X kernel written in HIP

```python
import math
import jax, jax.numpy as jnp
from jax import lax
import numpy as np

D_MODEL = 1024
BATCH = 8
SEQ = 4096
DEPTH = 1

N_META = 16
BLOCK = 128
PAD = BLOCK - N_META
CHUNK = 64
HG_HEADS = D_MODEL // 128
HG_DK = 128
HG_DV = 128
HG_KDIM = HG_HEADS * HG_DK
HG_WIDTH = HG_HEADS * HG_DV
DA_HEADS = D_MODEL // 128
DA_D = 64
DA_WIDTH = DA_HEADS * 2 * DA_D
ROPE_DIM = DA_D // 4
ROPE_THETA = 500000.0
EPS = 1e-6
PROJ_SIZES = (HG_KDIM, HG_KDIM, HG_WIDTH, HG_WIDTH,
              DA_WIDTH, DA_WIDTH, DA_WIDTH, DA_WIDTH, D_MODEL, D_MODEL)
PROJ_WIDTH = sum(PROJ_SIZES)

kernel_name = "hgrn2_diffattn_gated_hybrid"


def rmsnorm(x, g):
    xf = x.astype(jnp.float32)
    y = xf * lax.rsqrt(jnp.mean(xf * xf, axis=-1, keepdims=True) + EPS)
    return (y * g.astype(jnp.float32)).astype(x.dtype)


def split_heads(a, n_heads):
    b, l, w = a.shape
    return a.reshape(b, l, n_heads, w // n_heads).transpose(0, 2, 1, 3)


def merge_heads(a):
    b, h, l, dh = a.shape
    return a.transpose(0, 2, 1, 3).reshape(b, l, h * dh)


def rope_partial(x, pos):
    half = ROPE_DIM // 2
    inv = ROPE_THETA ** (-jnp.arange(half, dtype=jnp.float32) * 2.0 / ROPE_DIM)
    ang = pos.astype(jnp.float32)[:, None] * inv[None, :]
    cos = jnp.cos(ang).astype(x.dtype)
    sin = jnp.sin(ang).astype(x.dtype)
    x1, x2, xp = x[..., :half], x[..., half:ROPE_DIM], x[..., ROPE_DIM:]
    return jnp.concatenate([x1 * cos - x2 * sin, x2 * cos + x1 * sin, xp], axis=-1)


def hgrn2_chunked(q, logf, k, v):
    B, H, L, DK = q.shape
    DV = v.shape[-1]
    n = L // CHUNK

    def to_chunks(a):
        return a.reshape(B, H, n, CHUNK, a.shape[-1]).transpose(2, 0, 1, 3, 4)

    causal = jnp.tril(jnp.ones((CHUNK, CHUNK), dtype=bool))[None, None, :, :, None]

    def step(S, inp):
        qb, gb, kb, vb = inp
        b = jnp.cumsum(gb, axis=2)
        rel = b[:, :, :, None, :] - b[:, :, None, :, :]
        dec = jnp.where(causal, jnp.exp(jnp.minimum(rel, 0.0)), 0.0)
        A = jnp.einsum('bhtd,bhsd,bhtsd->bhts', qb, kb, dec)
        o = (jnp.einsum('bhts,bhsv->bhtv', A, vb)
             + jnp.einsum('bhtd,bhdv->bhtv', qb * jnp.exp(b), S))
        bl = b[:, :, -1:, :]
        S_new = (jnp.exp(bl[:, :, 0, :])[..., None] * S
                 + jnp.einsum('bhsd,bhsv->bhdv', kb * jnp.exp(bl - b), vb))
        return S_new, o

    S0 = jnp.zeros((B, H, DK, DV), jnp.float32)
    _, oc = lax.scan(step, S0, (to_chunks(q), to_chunks(logf), to_chunks(k), to_chunks(v)))
    return oc.transpose(1, 2, 0, 3, 4).reshape(B, H, L, DV)


def diff_attention(q1, k1, q2, k2, v, lam):
    L = q1.shape[2]
    d = q1.shape[-1]
    n = L // BLOCK
    scale = d ** -0.5
    key_idx = jnp.arange(L)
    valid_key = key_idx >= PAD

    def block(i):
        s0 = i * BLOCK
        qb1 = lax.dynamic_slice_in_dim(q1, s0, BLOCK, axis=2)
        qb2 = lax.dynamic_slice_in_dim(q2, s0, BLOCK, axis=2)
        qidx = s0 + jnp.arange(BLOCK)
        mask = valid_key[None, :] & (key_idx[None, :] <= qidx[:, None])

        def probs(qb, kk):
            s = jnp.einsum('bhqd,bhkd->bhqk', qb, kk).astype(jnp.float32) * scale
            return jax.nn.softmax(jnp.where(mask, s, -1e30), axis=-1)

        p = probs(qb1, k1) - lam * probs(qb2, k2)
        return jnp.einsum('bhqk,bhkv->bhqv', p.astype(v.dtype), v)

    out = lax.map(block, jnp.arange(n))
    B, H = q1.shape[0], q1.shape[1]
    return out.transpose(1, 2, 0, 3, 4).reshape(B, H, L, v.shape[-1])


def setup_inputs(seed: int = 0) -> dict:
    key = jax.random.key(seed)
    ks = jax.random.split(key, 14)
    f32 = jnp.float32
    nrm = lambda k, shape, s: jax.random.normal(k, shape, f32) * s
    return {
        "x": nrm(ks[0], (BATCH, SEQ, D_MODEL), 1.0),
        "meta_tokens": nrm(ks[1], (N_META, D_MODEL), 1.0),
        "norm_g": 1.0 + nrm(ks[2], (DEPTH, D_MODEL), 0.02),
        "w_in": nrm(ks[3], (DEPTH, D_MODEL, PROJ_WIDTH), D_MODEL ** -0.5),
        "hg_lb_logits": nrm(ks[4], (DEPTH + 1, HG_KDIM), 0.5),
        "hg_norm_g": 1.0 + nrm(ks[5], (DEPTH, HG_DV), 0.02),
        "da_lambda": nrm(ks[6], (DEPTH, 4, DA_D), 0.1),
        "da_norm_g": 1.0 + nrm(ks[7], (DEPTH, 2 * DA_D), 0.02),
        "w_branch_a": nrm(ks[8], (DEPTH, HG_WIDTH, D_MODEL), HG_WIDTH ** -0.5),
        "w_branch_b": nrm(ks[9], (DEPTH, DA_WIDTH, D_MODEL), DA_WIDTH ** -0.5),
        "w_out": nrm(ks[10], (DEPTH, D_MODEL, D_MODEL), D_MODEL ** -0.5),
        "final_g": 1.0 + nrm(ks[11], (D_MODEL,), 0.02),
    }


def reference(x, meta_tokens, norm_g, w_in, hg_lb_logits, hg_norm_g, da_lambda,
              da_norm_g, w_branch_a, w_branch_b, w_out, final_g):
    B, S, D = x.shape
    dt = x.dtype
    h = jnp.concatenate([jnp.zeros((B, PAD, D), dt),
                         jnp.broadcast_to(meta_tokens.astype(dt)[None], (B, N_META, D)),
                         x], axis=1)
    Lp = h.shape[1]
    idx = jnp.arange(Lp)
    valid = idx >= PAD
    pos = jnp.maximum(idx - PAD, 0)
    offs = [int(o) for o in np.cumsum(PROJ_SIZES)[:-1]]
    lb_all = jnp.cumsum(jax.nn.softmax(hg_lb_logits.astype(jnp.float32), axis=0), axis=0)

    for l in range(DEPTH):
        u = rmsnorm(h, norm_g[l])
        proj = jnp.einsum('bld,de->ble', u, w_in[l])
        hq, hf, hi, hz, aq, ak, av, az, ga, gb = jnp.split(proj, offs, axis=-1)

        lb = lb_all[l]
        f = lb + (1.0 - lb) * jax.nn.sigmoid(hf.astype(jnp.float32))
        f = jnp.where(valid[None, :, None], f, 1.0)
        kA = 1.0 - f
        oA = hgrn2_chunked(split_heads(hq.astype(jnp.float32), HG_HEADS),
                           split_heads(jnp.log(f), HG_HEADS),
                           split_heads(kA, HG_HEADS),
                           split_heads(hi.astype(jnp.float32), HG_HEADS))
        oA = merge_heads(rmsnorm(oA.astype(dt), hg_norm_g[l]))
        yA = jnp.einsum('blw,wd->bld', oA * jax.nn.silu(hz), w_branch_a[l])

        lam_init = 0.8 - 0.6 * math.exp(-0.3 * l)
        lp = da_lambda[l].astype(jnp.float32)
        lam = jnp.exp(jnp.sum(lp[0] * lp[1])) - jnp.exp(jnp.sum(lp[2] * lp[3])) + lam_init
        qh = split_heads(aq, DA_HEADS)
        kh = split_heads(ak, DA_HEADS)
        vh = split_heads(av, DA_HEADS)
        q1 = rope_partial(qh[..., :DA_D], pos)
        q2 = rope_partial(qh[..., DA_D:], pos)
        k1 = rope_partial(kh[..., :DA_D], pos)
        k2 = rope_partial(kh[..., DA_D:], pos)
        oB = diff_attention(q1, k1, q2, k2, vh, lam)
        oB = merge_heads(rmsnorm(oB, da_norm_g[l]) * (1.0 - lam_init))
        yB = jnp.einsum('blw,wd->bld', oB * jax.nn.silu(az), w_branch_b[l])

        m = jax.nn.sigmoid(ga) * yA + jax.nn.sigmoid(gb) * yB
        h = h + jnp.einsum('bld,de->ble', m, w_out[l])

    out = rmsnorm(h, final_g)
    return out[:, PAD + N_META:, :]
```

```cpp
#include <hip/hip_runtime.h>
#include <hip/hip_cooperative_groups.h>
#include <cstdio>
#include <cstdint>
#include <type_traits>
namespace cg = cooperative_groups;
namespace pg8 {
#define PG8_LAS __attribute__((address_space(3)))
typedef unsigned short bf16_t;
typedef short bf16x8 __attribute__((ext_vector_type(8)));
typedef float f32x4 __attribute__((ext_vector_type(4)));
typedef unsigned u32x4 __attribute__((ext_vector_type(4)));
constexpr int BM = 256, BK = 64, HALF = 128, HTB = HALF * BK * 2  , STAGE_BYTES = 8 * HTB, NXCD = 8, WGM = 8;

__host__ __device__ __forceinline__ int lds_byte(int r, int c) { const int st = (r >> 4) * 2 + (c >> 5), rr = r & 15, cc = c & 31, ob = rr * 64 + cc * 2; return st * 1024 + (ob ^ (((ob >> 9) & 1) << 5)); }
__host__ __device__ __forceinline__ void stage_rc(int b, int& R, int& C) { const int st = b / 1024, sb = b % 1024, swz = sb ^ (((sb >> 9) & 1) << 5); R = (st >> 1) * 16 + swz / 64; C = (st & 1) * 32 + (swz % 64) / 2; }
__host__ __device__ __forceinline__ int perm32(int rho) { const int n = rho >> 4, i = rho & 15; return 8 * (i >> 2) + 4 * n + (i & 3); }

struct Unit { int pm, pn; };
struct Gemm { const bf16_t* A; const bf16_t* Bt; int M, N, K; };

struct StaticOrder {
    int nM, nN, nwg, G, c;
    __host__ __device__ void init(int M, int N, int G_, int c_) { nM = M / BM; nN = N / BM; nwg = nM * nN; G = G_; c = c_; }
    __host__ __device__ bool next(int i, Unit& u) const {
        const long L = (long)i * G + c; if (L >= nwg) return false;
        int wgid = (int)L; { const int q = nwg / NXCD, r = nwg % NXCD, xcd = wgid % NXCD, off = wgid / NXCD; wgid = (xcd < r ? xcd * (q + 1) : r * (q + 1) + (xcd - r) * q) + off; }
        const int nig = WGM * nN, gid = wgid / nig, fm = gid * WGM, gsz = (nM - fm) < WGM ? (nM - fm) : WGM;
        u.pm = fm + ((wgid % nig) % gsz); u.pn = (wgid % nig) / gsz; return true;
    }
    __device__ __forceinline__ void a_ready(const Unit&) const {}
    __device__ __forceinline__ void done(const Unit&) const {}
};

__device__ __forceinline__ unsigned cvt_pk_bf16(float lo, float hi) { unsigned r; asm volatile("v_cvt_pk_bf16_f32 %0, %1, %2" : "=v"(r) : "v"(lo), "v"(hi)); return r; }
typedef float f32x2 __attribute__((ext_vector_type(2)));
template <class Epi, class Sched, bool ALIGN_EPI = false, bool SP2 = false>
__device__ __forceinline__ void gemm_phase(PG8_LAS unsigned char* lds, const Gemm g, const Sched& S, const Epi& E) {
    const int tid = threadIdx.x, wid = __builtin_amdgcn_readfirstlane(tid >> 6), lane = tid & 63, wr = wid >> 2, wc = wid & 3, fr = lane & 15, fq = lane >> 4;
    const int K = g.K, nt = K / BK;
    unsigned voffA[2], voffB[2];
#pragma unroll
    for (int i = 0; i < 2; ++i) { int R, C; stage_rc(tid * 16 + i * 8192, R, C); const int Rb = Epi::PERM ? ((R & ~31) + perm32(R & 31)) : R;
        voffA[i] = (unsigned)(R * K + C) * 2u; voffB[i] = (unsigned)(Rb * K + C) * 2u; }
    const size_t kstep = (size_t)(BK * 2);
    const size_t hstep = (size_t)HALF * K * 2;
    const size_t tstep = 2 * hstep;
    const unsigned ldsw = (unsigned)wid * 1024u;
    const int aoff = lds_byte(wr * 64 + fr, fq * 8), boff = lds_byte(wc * 32 + fr, fq * 8);
#define PG8_SA(b, h) (((b) * 2 + (h)) * HTB)
#define PG8_SB(b, h) ((4 + (b) * 2 + (h)) * HTB)
#define PG8_STAGE(bufoff, gbase, voff) do { _Pragma("unroll") for (int _i = 0; _i < 2; ++_i) \
        __builtin_amdgcn_global_load_lds((const unsigned*)((const char*)(gbase) + (voff)[_i]), (PG8_LAS unsigned*)(lds + (bufoff) + ldsw + _i * 8192), 16, 0, 0); } while (0)
#define PG8_LDA(dst, b, h) do { _Pragma("unroll") for (int m = 0; m < 4; ++m) _Pragma("unroll") for (int k = 0; k < 2; ++k) dst[m][k] = *(const PG8_LAS bf16x8*)(lds + PG8_SA(b, h) + aoff + m * 2048 + k * 1024); } while (0)
#define PG8_LDB(dst, b, h) do { _Pragma("unroll") for (int n = 0; n < 2; ++n) _Pragma("unroll") for (int k = 0; k < 2; ++k) dst[n][k] = *(const PG8_LAS bf16x8*)(lds + PG8_SB(b, h) + boff + n * 2048 + k * 1024); } while (0)
#define PG8_MMA(ai, bj, At, Bt) do { __builtin_amdgcn_s_setprio(1); _Pragma("unroll") for (int m = 0; m < 4; ++m) _Pragma("unroll") for (int n = 0; n < 2; ++n) _Pragma("unroll") for (int k = 0; k < 2; ++k) \
        acc[ai][bj][m][n] = __builtin_amdgcn_mfma_f32_16x16x32_bf16(Bt[n][k], At[m][k], acc[ai][bj][m][n], 0, 0, 0); __builtin_amdgcn_s_setprio(0); } while (0)
#define PG8_WAIT_V(n) asm volatile("s_waitcnt vmcnt(" #n ")" ::: "memory")
#define PG8_WAIT_L(n) asm volatile("s_waitcnt lgkmcnt(" #n ")" ::: "memory")
#define PG8_BAR __builtin_amdgcn_s_barrier()
#define PG8_SCHED __builtin_amdgcn_sched_barrier(0)
    Unit cur, nxt; int ui = 0;
    if (!S.next(0, cur)) return;
    f32x4 acc[2][2][4][2];
#pragma unroll
    for (int a = 0; a < 2; ++a)
#pragma unroll
        for (int b = 0; b < 2; ++b)
#pragma unroll
            for (int m = 0; m < 4; ++m)
#pragma unroll
                for (int n = 0; n < 2; ++n) acc[a][b][m][n] = (f32x4){0.f, 0.f, 0.f, 0.f};
    bf16x8 At[4][2], B0[2][2], B1[2][2];
    const char* cA = (const char*)g.A + (size_t)cur.pm * tstep; const char* cB = (const char*)g.Bt + (size_t)cur.pn * tstep;
    S.a_ready(cur);
    if constexpr (SP2) {
        PG8_STAGE(PG8_SB(0, 0), cB, voffB); PG8_STAGE(PG8_SB(0, 1), cB + hstep, voffB); PG8_STAGE(PG8_SA(0, 0), cA, voffA); PG8_STAGE(PG8_SA(0, 1), cA + hstep, voffA);
        if (wr == 1) PG8_BAR;
        PG8_WAIT_V(2); PG8_BAR;
        PG8_STAGE(PG8_SB(1, 0), cB + kstep, voffB); PG8_STAGE(PG8_SA(1, 0), cA + kstep, voffA); PG8_STAGE(PG8_SB(1, 1), cB + hstep + kstep, voffB);
        PG8_WAIT_V(6); PG8_BAR;
    } else {
        PG8_STAGE(PG8_SB(0, 0), cB, voffB); PG8_STAGE(PG8_SA(0, 0), cA, voffA); PG8_STAGE(PG8_SB(0, 1), cB + hstep, voffB); PG8_STAGE(PG8_SA(0, 1), cA + hstep, voffA);
        if (wr == 1) PG8_BAR;
        PG8_WAIT_V(4); PG8_BAR;
        PG8_STAGE(PG8_SB(1, 0), cB + kstep, voffB); PG8_STAGE(PG8_SA(1, 0), cA + kstep, voffA); PG8_STAGE(PG8_SB(1, 1), cB + hstep + kstep, voffB);
        PG8_WAIT_V(6); PG8_BAR;
    }
    for (;;) {
        const bool has_next = S.next(ui + 1, nxt);
        const char* nA = has_next ? (const char*)g.A + (size_t)nxt.pm * tstep : cA; const char* nB = has_next ? (const char*)g.Bt + (size_t)nxt.pn * tstep : cB;
        for (int t = 0; t < nt; t += 2) {
            const bool last = (t == nt - 2);
            const char* a1 = cA + (size_t)(t + 1) * kstep;
            const char* a2 = last ? nA : cA + (size_t)(t + 2) * kstep; const char* b2 = last ? nB : cB + (size_t)(t + 2) * kstep;
            const char* a3 = a2 + kstep; const char* b3 = b2 + kstep;
            if (last && has_next) S.a_ready(nxt);
            if constexpr (SP2) {
            PG8_LDB(B0, 0, 0); PG8_LDB(B1, 0, 1); PG8_SCHED; PG8_LDA(At, 0, 0); PG8_STAGE(PG8_SA(1, 1), a1 + hstep, voffA);
            PG8_WAIT_V(8); PG8_WAIT_L(0); PG8_BAR; PG8_MMA(0, 0, At, B0); PG8_MMA(0, 1, At, B1); PG8_BAR; PG8_SCHED;
            PG8_LDA(At, 0, 1); PG8_STAGE(PG8_SB(0, 0), b2, voffB); PG8_STAGE(PG8_SB(0, 1), b2 + hstep, voffB); PG8_STAGE(PG8_SA(0, 0), a2, voffA);
            PG8_WAIT_V(8); PG8_WAIT_L(0); PG8_BAR; PG8_MMA(1, 0, At, B0); PG8_MMA(1, 1, At, B1); PG8_BAR; PG8_SCHED;
            PG8_LDB(B0, 1, 0); PG8_LDB(B1, 1, 1); PG8_SCHED; PG8_LDA(At, 1, 0); PG8_STAGE(PG8_SA(0, 1), a2 + hstep, voffA);
            PG8_WAIT_V(8); PG8_WAIT_L(0); PG8_BAR; PG8_MMA(0, 0, At, B0); PG8_MMA(0, 1, At, B1); PG8_BAR; PG8_SCHED;
            PG8_LDA(At, 1, 1); PG8_STAGE(PG8_SB(1, 0), b3, voffB); PG8_STAGE(PG8_SB(1, 1), b3 + hstep, voffB); PG8_STAGE(PG8_SA(1, 0), a3, voffA);
            PG8_WAIT_V(8); PG8_WAIT_L(0); PG8_BAR; PG8_MMA(1, 0, At, B0); PG8_MMA(1, 1, At, B1); PG8_BAR; PG8_SCHED;
            } else {
            PG8_LDB(B0, 0, 0); PG8_SCHED; PG8_LDA(At, 0, 0); PG8_STAGE(PG8_SA(1, 1), a1 + hstep, voffA);
            PG8_WAIT_L(8); PG8_BAR; PG8_WAIT_L(0); PG8_MMA(0, 0, At, B0); PG8_BAR; PG8_SCHED;
            PG8_LDB(B1, 0, 1); PG8_STAGE(PG8_SB(0, 0), b2, voffB);
            PG8_BAR; PG8_WAIT_L(0); PG8_MMA(0, 1, At, B1); PG8_BAR;
            PG8_LDA(At, 0, 1); PG8_STAGE(PG8_SA(0, 0), a2, voffA);
            PG8_BAR; PG8_WAIT_L(0); PG8_MMA(1, 0, At, B0); PG8_BAR; PG8_SCHED;
            PG8_STAGE(PG8_SB(0, 1), b2 + hstep, voffB);
            PG8_WAIT_V(6); PG8_BAR; PG8_MMA(1, 1, At, B1); PG8_BAR;
            PG8_LDB(B0, 1, 0); PG8_SCHED; PG8_LDA(At, 1, 0); PG8_STAGE(PG8_SA(0, 1), a2 + hstep, voffA);
            PG8_WAIT_L(8); PG8_BAR; PG8_WAIT_L(0); PG8_MMA(0, 0, At, B0); PG8_BAR; PG8_SCHED;
            PG8_LDB(B1, 1, 1); PG8_STAGE(PG8_SB(1, 0), b3, voffB);
            PG8_BAR; PG8_WAIT_L(0); PG8_MMA(0, 1, At, B1); PG8_BAR;
            PG8_LDA(At, 1, 1); PG8_STAGE(PG8_SA(1, 0), a3, voffA);
            PG8_BAR; PG8_WAIT_L(0); PG8_MMA(1, 0, At, B0); PG8_BAR; PG8_SCHED;
            PG8_STAGE(PG8_SB(1, 1), b3 + hstep, voffB);
            PG8_WAIT_V(6); PG8_BAR; PG8_MMA(1, 1, At, B1); PG8_BAR;
            }
        }
        if constexpr (ALIGN_EPI) { if (wr == 0) PG8_BAR; }
        if constexpr (!Epi::AFTER_DRAIN) { E(acc, cur, wr, wc, fr, fq); S.done(cur); }
        if (!has_next) break;
#pragma unroll
        for (int a = 0; a < 2; ++a)
#pragma unroll
            for (int b = 0; b < 2; ++b)
#pragma unroll
                for (int m = 0; m < 4; ++m)
#pragma unroll
                    for (int n = 0; n < 2; ++n) acc[a][b][m][n] = (f32x4){0.f, 0.f, 0.f, 0.f};
        cur = nxt; cA = nA; cB = nB; ++ui;
        if constexpr (ALIGN_EPI) { if (wr == 1) PG8_BAR; }
    }
    PG8_WAIT_V(0);
    if constexpr (!ALIGN_EPI) { if (wr == 0) PG8_BAR; }
    PG8_BAR;
    if constexpr (Epi::AFTER_DRAIN) { E.fused(acc, cur, wr, wc, fr, fq, lds, wid, lane); S.done(cur); }
#undef PG8_SA
#undef PG8_SB
#undef PG8_STAGE
#undef PG8_LDA
#undef PG8_LDB
#undef PG8_MMA
#undef PG8_WAIT_V
#undef PG8_WAIT_L
#undef PG8_BAR
#undef PG8_SCHED
}
}

#define LAS __attribute__((address_space(3)))
typedef unsigned short bf16_t;
typedef short bf16x8 __attribute__((ext_vector_type(8)));
typedef short s16x4 __attribute__((ext_vector_type(4)));
typedef float f32x4 __attribute__((ext_vector_type(4)));
typedef float f32x2v __attribute__((ext_vector_type(2)));
typedef float f32x16 __attribute__((ext_vector_type(16)));
typedef unsigned u32x4 __attribute__((ext_vector_type(4)));
typedef unsigned u32x2 __attribute__((ext_vector_type(2)));
typedef LAS unsigned char* ldsp;

constexpr int NB = 8, SEQ = 4096, DM = 1024, LP = 4224, PADN = 112;
constexpr int MREAL = NB * SEQ;
constexpr int MU = 33024;
constexpr size_t MiB = 1u << 20;
constexpr size_t WS_CTL = 0;
constexpr size_t WS_LB = 4096;
constexpr size_t WS_ROPE = 8192;
constexpr size_t WS_WIN = 1 * MiB;
constexpr size_t WS_WA = 21 * MiB, WS_WB = 23 * MiB, WS_WO = 25 * MiB;
constexpr size_t WS_U = 27 * MiB;
constexpr size_t WS_P = 92 * MiB;
constexpr size_t PSTRIDE = (size_t)NB * LP * DM;
constexpr size_t P3STRIDE = (size_t)MREAL * DM;
constexpr size_t WS_SSQ = 496 * MiB;
constexpr size_t WS_NEED = 506 * MiB;
constexpr float LOG2E = 1.4426950408889634f;
constexpr float QSCALE = 0.125f * LOG2E;
constexpr int LDS_BYTES = 131072 + 1024;

#define LBAR() do { asm volatile("s_waitcnt lgkmcnt(0)" ::: "memory"); __builtin_amdgcn_s_barrier(); asm volatile("" ::: "memory"); } while (0)
__device__ __forceinline__ float wave_sum(float v) {
#pragma unroll
    for (int o = 1; o < 64; o <<= 1) v += __shfl_xor(v, o);
    return v;
}
__device__ __forceinline__ unsigned pk2(float lo, float hi) { return pg8::cvt_pk_bf16(lo, hi); }
__device__ __forceinline__ float bflo(unsigned u) { return __builtin_bit_cast(float, u << 16); }
__device__ __forceinline__ float bfhi(unsigned u) { return __builtin_bit_cast(float, u & 0xffff0000u); }
__device__ __forceinline__ float h2f(unsigned short h) { return (float)__builtin_bit_cast(_Float16, h); }
__device__ __forceinline__ unsigned short f2h(float f) { return __builtin_bit_cast(unsigned short, (_Float16)f); }
__device__ __forceinline__ float fexp2(float x) { return __builtin_amdgcn_exp2f(x); }
__device__ __forceinline__ float sigmoidf_(float x) { return __builtin_amdgcn_rcpf(1.0f + fexp2(-x * LOG2E)); }

namespace pg8 {
template <int N> __device__ __forceinline__ float row_shr(float v) {
    return __builtin_bit_cast(float, __builtin_amdgcn_update_dpp(0, __builtin_bit_cast(int, v), 0x110 + N, 0xf, 0xf, true));
}
struct EpiProj {
    static constexpr bool PERM = true, AFTER_DRAIN = false;
    bf16_t* P; const float* lb; const float* rope; float* EVG;
    __device__ __forceinline__ void operator()(const f32x4 (&acc)[2][2][4][2], const Unit& u, int wr, int wc, int fr, int fq) const {
        const int lane = fr + 16 * fq;
        if (u.pn < 8) {
            const int head = u.pn, ch0 = 32 * wc + 8 * fq;
            const f32x4 lb0 = *(const f32x4*)(lb + head * 128 + ch0), lb1 = *(const f32x4*)(lb + head * 128 + ch0 + 4);
#pragma unroll
            for (int ai = 0; ai < 2; ++ai) {
                const int rp0 = u.pm * BM + ai * HALF + wr * 64;
                const int bb = rp0 >> 12, s0 = rp0 & 4095, cidx = 2 + (s0 >> 6);
                unsigned qpk[4][4], kpk[4][4]; float qev[4], kev[4];
                float emid[8], el[8], elm[8];
#pragma unroll
                for (int e = 0; e < 8; ++e) {
                    const float lbv = e < 4 ? lb0[e] : lb1[e - 4];
                    float f[4], bcs[4], carry = 0.f, ref = 0.f;
#pragma unroll
                    for (int m = 0; m < 4; ++m) {
                        f[m] = lbv + (1.0f - lbv) * sigmoidf_(acc[ai][1][m][e >> 2][e & 3]);
                        float v = __logf(f[m]);
                        v += row_shr<1>(v); v += row_shr<2>(v); v += row_shr<4>(v); v += row_shr<8>(v);
                        v += carry; bcs[m] = v;
                        carry = __shfl(v, (lane & 48) | 15);
                        if (m == 1) ref = carry;
                    }
                    const float bl = carry;
                    emid[e] = fexp2(ref * LOG2E); el[e] = fexp2(bl * LOG2E); elm[e] = fexp2(fmaxf(bl - ref, -100.f) * LOG2E);
#pragma unroll
                    for (int m = 0; m < 4; ++m) {
                        const float d = fminf(fmaxf(bcs[m] - ref, -80.f), 80.f);
                        const float e1 = fexp2(d * LOG2E), e2 = __builtin_amdgcn_rcpf(e1);
                        const float qe = acc[ai][0][m][e >> 2][e & 3] * e1, ke = (1.0f - f[m]) * e2;
                        if (e & 1) { qpk[m][e >> 1] = cvt_pk_bf16(qev[m], qe); kpk[m][e >> 1] = cvt_pk_bf16(kev[m], ke); }
                        else { qev[m] = qe; kev[m] = ke; }
                    }
                }
#pragma unroll
                for (int m = 0; m < 4; ++m) {
                    const size_t off = ((size_t)(bb * 8 + head) * LP + 128 + s0 + m * 16 + fr) * 128 + ch0;
                    *(u32x4*)(P + off) = (u32x4){qpk[m][0], qpk[m][1], qpk[m][2], qpk[m][3]};
                    *(u32x4*)(P + PSTRIDE + off) = (u32x4){kpk[m][0], kpk[m][1], kpk[m][2], kpk[m][3]};
                }
                if (fr == 15) {
                    float* ev = EVG + ((size_t)((bb * 8 + head) * 66 + cidx)) * 384 + ch0;
                    *(f32x4*)(ev) = (f32x4){emid[0], emid[1], emid[2], emid[3]}; *(f32x4*)(ev + 4) = (f32x4){emid[4], emid[5], emid[6], emid[7]};
                    *(f32x4*)(ev + 128) = (f32x4){el[0], el[1], el[2], el[3]}; *(f32x4*)(ev + 132) = (f32x4){el[4], el[5], el[6], el[7]};
                    *(f32x4*)(ev + 256) = (f32x4){elm[0], elm[1], elm[2], elm[3]}; *(f32x4*)(ev + 260) = (f32x4){elm[4], elm[5], elm[6], elm[7]};
                }
            }
            return;
        }
        const int seg = 2 + ((u.pn - 8) >> 2), cseg = ((u.pn - 8) & 3) * BM;
        bf16_t* base = P + (size_t)seg * PSTRIDE;
        const bool ropewave = ((seg == 3) || (seg == 4)) && ((wc & 1) == 0);
#pragma unroll
        for (int ai = 0; ai < 2; ++ai)
#pragma unroll
            for (int m = 0; m < 4; ++m) {
                const int rp = u.pm * BM + ai * HALF + wr * 64 + m * 16 + fr;
                const int bb = rp >> 12, s = rp & 4095;
                const int pos = 16 + s;
#pragma unroll
                for (int bj = 0; bj < 2; ++bj) {
                    const int c0 = cseg + bj * HALF + wc * 32 + 8 * fq;
                    float x[8];
#pragma unroll
                    for (int i = 0; i < 4; ++i) { x[i] = acc[ai][bj][m][0][i]; x[4 + i] = acc[ai][bj][m][1][i]; }
                    if (ropewave) {
                        float p[8];
#pragma unroll
                        for (int i = 0; i < 8; ++i) p[i] = __shfl_xor(x[i], 16);
                        if (fq < 2) {
                            const float* rt = rope + (size_t)pos * 16;
                            const f32x4 c0v = *(const f32x4*)(rt), c1v = *(const f32x4*)(rt + 4), s0v = *(const f32x4*)(rt + 8), s1v = *(const f32x4*)(rt + 12);
                            const float sg = fq == 0 ? -1.0f : 1.0f;
#pragma unroll
                            for (int i = 0; i < 8; ++i) { const float cs = i < 4 ? c0v[i] : c1v[i - 4], sn = i < 4 ? s0v[i] : s1v[i - 4];
                                x[i] = x[i] * cs + sg * p[i] * sn; }
                        }
                    }
                    if (seg == 3) {
#pragma unroll
                        for (int i = 0; i < 8; ++i) x[i] *= QSCALE;
                    }
                    u32x4 w; w.x = cvt_pk_bf16(x[0], x[1]); w.y = cvt_pk_bf16(x[2], x[3]); w.z = cvt_pk_bf16(x[4], x[5]); w.w = cvt_pk_bf16(x[6], x[7]);
                    *(u32x4*)(base + ((size_t)(bb * 8 + (c0 >> 7)) * LP + 128 + s) * 128 + (c0 & 127)) = w;
                }
            }
    }
};
struct EpiGate {
    static constexpr bool PERM = true, AFTER_DRAIN = false;
    bf16_t* T; const bf16_t* OAB; const float* RST;
    __device__ __forceinline__ void operator()(const f32x4 (&acc)[2][2][4][2], const Unit& u, int wr, int wc, int fr, int fq) const {
        const int colt = u.pn * BM, seg = colt >> 10, cseg = colt & 1023;
        bf16_t* base = T + (size_t)seg * P3STRIDE;
        const bf16_t* ob = OAB + (size_t)(seg & 1) * P3STRIDE;
#pragma unroll
        for (int ai = 0; ai < 2; ++ai) {
            u32x4 ov[4][2]; float rn[4][2];
            if (seg < 2) {
#pragma unroll
                for (int m = 0; m < 4; ++m)
#pragma unroll
                    for (int bj = 0; bj < 2; ++bj) {
                        const int rp = u.pm * BM + ai * HALF + wr * 64 + m * 16 + fr, c0 = cseg + bj * HALF + wc * 32 + 8 * fq;
                        ov[m][bj] = *(const u32x4*)(ob + (size_t)rp * DM + c0);
                        rn[m][bj] = seg == 0 ? RST[(size_t)((rp >> 12) * 8 + (c0 >> 7)) * SEQ + (rp & 4095)] : 1.0f;
                    }
            }
#pragma unroll
            for (int m = 0; m < 4; ++m) {
                const int rp = u.pm * BM + ai * HALF + wr * 64 + m * 16 + fr;
#pragma unroll
                for (int bj = 0; bj < 2; ++bj) {
                    const int c0 = cseg + bj * HALF + wc * 32 + 8 * fq;
                    const size_t off = (size_t)rp * DM + c0;
                    float x[8];
#pragma unroll
                    for (int i = 0; i < 4; ++i) { x[i] = acc[ai][bj][m][0][i]; x[4 + i] = acc[ai][bj][m][1][i]; }
                    if (seg < 2) {
                        const u32x4 o = ov[m][bj];
                        const float ovv[8] = {bflo(o.x), bfhi(o.x), bflo(o.y), bfhi(o.y), bflo(o.z), bfhi(o.z), bflo(o.w), bfhi(o.w)};
#pragma unroll
                        for (int i = 0; i < 8; ++i) x[i] = x[i] * sigmoidf_(x[i]) * ovv[i] * rn[m][bj];
                    } else {
#pragma unroll
                        for (int i = 0; i < 8; ++i) x[i] = sigmoidf_(x[i]);
                    }
                    u32x4 w; w.x = cvt_pk_bf16(x[0], x[1]); w.y = cvt_pk_bf16(x[2], x[3]); w.z = cvt_pk_bf16(x[4], x[5]); w.w = cvt_pk_bf16(x[6], x[7]);
                    *(u32x4*)(base + off) = w;
                }
            }
        }
    }
};
template <int STEP> struct EpiMix {
    static constexpr bool PERM = true, AFTER_DRAIN = false;
    bf16_t* M; const bf16_t* SG;
    __device__ __forceinline__ void operator()(const f32x4 (&acc)[2][2][4][2], const Unit& u, int wr, int wc, int fr, int fq) const {
        const int colt = u.pn * BM;
#pragma unroll
        for (int ai = 0; ai < 2; ++ai) {
            u32x4 gq[4][2], pq[4][2];
#pragma unroll
            for (int m = 0; m < 4; ++m)
#pragma unroll
                for (int bj = 0; bj < 2; ++bj) {
                    const size_t off = (size_t)(u.pm * BM + ai * HALF + wr * 64 + m * 16 + fr) * DM + colt + bj * HALF + wc * 32 + 8 * fq;
                    gq[m][bj] = *(const u32x4*)(SG + off);
                    if (STEP == 1) pq[m][bj] = *(const u32x4*)(M + off);
                }
#pragma unroll
            for (int m = 0; m < 4; ++m)
#pragma unroll
                for (int bj = 0; bj < 2; ++bj) {
                    const size_t off = (size_t)(u.pm * BM + ai * HALF + wr * 64 + m * 16 + fr) * DM + colt + bj * HALF + wc * 32 + 8 * fq;
                    float x[8];
#pragma unroll
                    for (int i = 0; i < 4; ++i) { x[i] = acc[ai][bj][m][0][i]; x[4 + i] = acc[ai][bj][m][1][i]; }
                    const u32x4 g = gq[m][bj];
                    const float gv[8] = {bflo(g.x), bfhi(g.x), bflo(g.y), bfhi(g.y), bflo(g.z), bfhi(g.z), bflo(g.w), bfhi(g.w)};
#pragma unroll
                    for (int i = 0; i < 8; ++i) x[i] *= gv[i];
                    if (STEP == 1) {
                        const u32x4 p = pq[m][bj];
                        const float pv[8] = {bflo(p.x), bfhi(p.x), bflo(p.y), bfhi(p.y), bflo(p.z), bfhi(p.z), bflo(p.w), bfhi(p.w)};
#pragma unroll
                        for (int i = 0; i < 8; ++i) x[i] += pv[i];
                    }
                    u32x4 w; w.x = cvt_pk_bf16(x[0], x[1]); w.y = cvt_pk_bf16(x[2], x[3]); w.z = cvt_pk_bf16(x[4], x[5]); w.w = cvt_pk_bf16(x[6], x[7]);
                    *(u32x4*)(M + off) = w;
                }
        }
    }
};
struct PairOrder {
    StaticOrder S;
    __host__ __device__ bool next(int i, Unit& u) const { if (i >= 4) return false; if (!S.next(i & 1, u)) return false; if (i >= 2) { u.pm += 128; u.pn += 4; } return true; }
    __device__ __forceinline__ void a_ready(const Unit&) const {}
    __device__ __forceinline__ void done(const Unit&) const {}
};
struct EpiMixPair {
    static constexpr bool PERM = true, AFTER_DRAIN = false;
    EpiMix<0> e0; EpiMix<1> e1;
    __device__ __forceinline__ void operator()(const f32x4 (&acc)[2][2][4][2], const Unit& u, int wr, int wc, int fr, int fq) const {
        if (u.pm < 128) e0(acc, u, wr, wc, fr, fq);
        else { Unit v; v.pm = u.pm - 128; v.pn = u.pn - 4; e1(acc, v, wr, wc, fr, fq); }
    }
};
struct EpiOut {
    static constexpr bool PERM = true, AFTER_DRAIN = false;
    const bf16_t* Ub; const float* rmsx; const float* ginv; bf16_t* H;
    __device__ __forceinline__ void operator()(const f32x4 (&acc)[2][2][4][2], const Unit& u, int wr, int wc, int fr, int fq) const {
        f32x4 gi[2][2];
#pragma unroll
        for (int bj = 0; bj < 2; ++bj) { const int c0 = u.pn * BM + bj * HALF + wc * 32 + 8 * fq; gi[bj][0] = *(const f32x4*)(ginv + c0); gi[bj][1] = *(const f32x4*)(ginv + c0 + 4); }
#pragma unroll
        for (int ai = 0; ai < 2; ++ai) {
            u32x4 uq[4][2]; float rm[4];
#pragma unroll
            for (int m = 0; m < 4; ++m) {
                const int rp = u.pm * BM + ai * HALF + wr * 64 + m * 16 + fr;
                rm[m] = rmsx[rp];
#pragma unroll
                for (int bj = 0; bj < 2; ++bj) uq[m][bj] = *(const u32x4*)(Ub + (size_t)rp * DM + u.pn * BM + bj * HALF + wc * 32 + 8 * fq);
            }
#pragma unroll
            for (int m = 0; m < 4; ++m) {
                const int rp = u.pm * BM + ai * HALF + wr * 64 + m * 16 + fr;
#pragma unroll
                for (int bj = 0; bj < 2; ++bj) {
                    const size_t off = (size_t)rp * DM + u.pn * BM + bj * HALF + wc * 32 + 8 * fq;
                    const u32x4 uv = uq[m][bj];
                    const f32x4 x0 = (f32x4){bflo(uv.x), bfhi(uv.x), bflo(uv.y), bfhi(uv.y)} * gi[bj][0] * rm[m] + acc[ai][bj][m][0], x1 = (f32x4){bflo(uv.z), bfhi(uv.z), bflo(uv.w), bfhi(uv.w)} * gi[bj][1] * rm[m] + acc[ai][bj][m][1];
                    u32x4 w; w.x = cvt_pk_bf16(x0[0], x0[1]); w.y = cvt_pk_bf16(x0[2], x0[3]); w.z = cvt_pk_bf16(x1[0], x1[1]); w.w = cvt_pk_bf16(x1[2], x1[3]);
                    *(u32x4*)(H + off) = w;
                }
            }
        }
    }
};
}

__device__ __forceinline__ void p0_transpose_item(const float* W, int K, int N, bf16_t* WT, int dst_row0, LAS float* scr, int k0, int n0, int lane) {
#pragma unroll
    for (int i = 0; i < 8; ++i) { const int kk = 8 * i + (lane >> 3), c4 = (lane & 7) * 4;
        const f32x4 v = *(const f32x4*)(W + (size_t)(k0 + kk) * N + n0 + c4);
        scr[kk * 33 + c4] = v.x; scr[kk * 33 + c4 + 1] = v.y; scr[kk * 33 + c4 + 2] = v.z; scr[kk * 33 + c4 + 3] = v.w; }
    asm volatile("s_waitcnt lgkmcnt(0)" ::: "memory");
    const int c = lane & 7;
#pragma unroll
    for (int j = 0; j < 4; ++j) { const int n = (lane >> 3) + 8 * j; const LAS float* s = scr + (8 * c) * 33 + n;
        u32x4 o; o.x = pk2(s[0 * 33], s[1 * 33]); o.y = pk2(s[2 * 33], s[3 * 33]); o.z = pk2(s[4 * 33], s[5 * 33]); o.w = pk2(s[6 * 33], s[7 * 33]);
        *(u32x4*)(WT + (size_t)(dst_row0 + n) * K + k0 + 8 * c) = o; }
    asm volatile("s_waitcnt lgkmcnt(0)" ::: "memory");
}
__device__ __forceinline__ void u_row(const float* xrow, const float* g, bf16_t* orow, int lane, float* rinv) {
    u32x2* o8 = (u32x2*)orow + lane;
    if (!xrow) {
#pragma unroll
        for (int j = 0; j < 4; ++j) o8[64 * j] = (u32x2){0u, 0u};
        return;
    }
    const f32x4* xr = (const f32x4*)xrow + lane; const f32x4* gr = (const f32x4*)g + lane;
    f32x4 v[4]; float s = 0.f;
#pragma unroll
    for (int j = 0; j < 4; ++j) { v[j] = xr[64 * j]; s += (v[j].x * v[j].x + v[j].y * v[j].y) + (v[j].z * v[j].z + v[j].w * v[j].w); }
    const float rms = sqrtf(wave_sum(s) * (1.0f / DM) + 1e-6f), rstd = 1.0f / rms;
    if (rinv && lane == 0) *rinv = rms;
#pragma unroll
    for (int j = 0; j < 4; ++j) { const f32x4 gv = gr[64 * j];
        o8[64 * j] = (u32x2){pk2(v[j].x * rstd * gv.x, v[j].y * rstd * gv.y), pk2(v[j].z * rstd * gv.z, v[j].w * rstd * gv.w)}; }
}
__device__ __forceinline__ void sincos_d(float af, float& sn, float& cs) {
    const double a = (double)af;
    const double k = __builtin_rint(a * 0.15915494309189535);
    const double r = a - k * 6.283185307179586;
    const double r2 = r * r;
    double s = 0.0, c = 0.0;
    double ts = 1.0, tc = 1.0;
#pragma unroll
    for (int n = 0; n < 16; ++n) {
        s += ts; c += tc;
        ts = -ts * r2 / (double)((2 * n + 2) * (2 * n + 3));
        tc = -tc * r2 / (double)((2 * n + 1) * (2 * n + 2));
    }
    sn = (float)(s * r); cs = (float)c;
}

constexpr size_t WS_EV = 489 * MiB;
__device__ __forceinline__ void hgrn_prep_unit(ldsp lds, bf16_t* HQ, bf16_t* LF, float* EVG, int b, int c, int h, int par) {
    const int tid = threadIdx.x, lane = tid & 63, w = __builtin_amdgcn_readfirstlane(tid >> 6);
    const size_t go0 = ((size_t)b * LP + 64 * c + 8 * w) * DM + h * 128 + 2 * lane;
    unsigned qv[8], lv[8];
#pragma unroll
    for (int i = 0; i < 8; ++i) { qv[i] = *(const unsigned*)(HQ + go0 + (size_t)i * DM); lv[i] = *(const unsigned*)(LF + go0 + (size_t)i * DM); }
    float b0[8], b1[8], r0 = 0.f, r1 = 0.f;
#pragma unroll
    for (int i = 0; i < 8; ++i) { r0 += h2f((unsigned short)(lv[i] & 0xffffu)); r1 += h2f((unsigned short)(lv[i] >> 16)); b0[i] = r0; b1[i] = r1; }
    ldsp wt = lds + par * 4096;
    *(LAS f32x2v*)(wt + (w * 128 + 2 * lane) * 4) = (f32x2v){r0, r1};
    LBAR();
    float pre0 = 0.f, pre1 = 0.f, ref0 = 0.f, ref1 = 0.f, bl0 = 0.f, bl1 = 0.f;
#pragma unroll
    for (int ww = 0; ww < 8; ++ww) { const f32x2v t = *(const LAS f32x2v*)(wt + (ww * 128 + 2 * lane) * 4);
        if (ww < w) { pre0 += t.x; pre1 += t.y; } if (ww < 4) { ref0 += t.x; ref1 += t.y; } bl0 += t.x; bl1 += t.y; }
    if (w == 0) {
        float* ev = EVG + ((size_t)((b * 8 + h) * 66 + c)) * 384 + 2 * lane;
        *(f32x2v*)(ev) = (f32x2v){fexp2(ref0 * LOG2E), fexp2(ref1 * LOG2E)};
        *(f32x2v*)(ev + 128) = (f32x2v){fexp2(bl0 * LOG2E), fexp2(bl1 * LOG2E)};
        *(f32x2v*)(ev + 256) = (f32x2v){fexp2(fmaxf(bl0 - ref0, -100.f) * LOG2E), fexp2(fmaxf(bl1 - ref1, -100.f) * LOG2E)};
    }
#pragma unroll
    for (int i = 0; i < 8; ++i) {
        const float d0 = fminf(fmaxf(pre0 + b0[i] - ref0, -80.f), 80.f), d1 = fminf(fmaxf(pre1 + b1[i] - ref1, -80.f), 80.f);
        const float e10 = fexp2(d0 * LOG2E), e11 = fexp2(d1 * LOG2E);
        const float e20 = __builtin_amdgcn_rcpf(e10), e21 = __builtin_amdgcn_rcpf(e11);
        const float k0 = 1.0f - fexp2(h2f((unsigned short)(lv[i] & 0xffffu)) * LOG2E), k1 = 1.0f - fexp2(h2f((unsigned short)(lv[i] >> 16)) * LOG2E);
        *(unsigned*)(HQ + go0 + (size_t)i * DM) = pk2(bflo(qv[i]) * e10, bfhi(qv[i]) * e11);
        *(unsigned*)(LF + go0 + (size_t)i * DM) = pk2(k0 * e20, k1 * e21);
    }
}

constexpr int HG_STR = 272;
constexpr int HG_QE = 0;
constexpr int HG_KE = HG_QE + 64 * HG_STR;
constexpr int HG_V = HG_KE + 64 * HG_STR;
constexpr int HG_A1 = HG_V + 64 * HG_STR, HG_TSTR = 144;
constexpr int HG_EV = HG_A1 + 64 * HG_TSTR;
constexpr int HG_SS = HG_EV + 3 * 128 * 4;
constexpr int HG_END = HG_SS + 8 * 64 * 4;
static_assert(HG_END <= 131072, "HGRN LDS");
typedef short v4i16_t __attribute__((ext_vector_type(4)));
__device__ __forceinline__ s16x4 vtr(ldsp p) { return __builtin_bit_cast(s16x4, __builtin_amdgcn_ds_read_tr16_b64_v4i16((LAS v4i16_t*)p)); }

__device__ __forceinline__ void hgrn_seq(ldsp lds, const bf16_t* HQ, const bf16_t* LF, const bf16_t* HI, const float* EVG, bf16_t* OA, float* SSQ, const float* gA, int b, int h) {
    const int tid = threadIdx.x, lane = tid & 63, w = __builtin_amdgcn_readfirstlane(tid >> 6), fr = lane & 15, fq = lane >> 4;
    const size_t rowb = (size_t)(b * 8 + h) * LP;
    f32x4 S[8];
#pragma unroll
    for (int i = 0; i < 8; ++i) S[i] = (f32x4){0.f, 0.f, 0.f, 0.f};
    const int srow = tid >> 3, sch = (tid & 7) * 2;
    const size_t gcol = (size_t)sch * 8;
    u32x4 rq0, rq1, rk0, rk1, rv0, rv1; f32x4 rev = (f32x4){0.f, 0.f, 0.f, 0.f};
#define HG_LOAD(c) do { const size_t go = (rowb + 64 * (c) + srow) * 128 + gcol; \
        rq0 = *(const u32x4*)(HQ + go); rq1 = *(const u32x4*)(HQ + go + 8); rk0 = *(const u32x4*)(LF + go); rk1 = *(const u32x4*)(LF + go + 8); \
        rv0 = *(const u32x4*)(HI + go); rv1 = *(const u32x4*)(HI + go + 8); \
        if (tid < 96) rev = *(const f32x4*)(EVG + ((size_t)((b * 8 + h) * 66 + (c))) * 384 + tid * 4); } while (0)
    HG_LOAD(1);
    const float gv = gA[16 * w + fr];
    const int trq = fr >> 2, trp = fr & 3;
    for (int c = 1; c <= 65; ++c) {
        LBAR();
        *(LAS u32x4*)(lds + HG_QE + srow * HG_STR + sch * 16) = rq0; *(LAS u32x4*)(lds + HG_QE + srow * HG_STR + sch * 16 + 16) = rq1;
        *(LAS u32x4*)(lds + HG_KE + srow * HG_STR + sch * 16) = rk0; *(LAS u32x4*)(lds + HG_KE + srow * HG_STR + sch * 16 + 16) = rk1;
        *(LAS u32x4*)(lds + HG_V + srow * HG_STR + sch * 16) = rv0; *(LAS u32x4*)(lds + HG_V + srow * HG_STR + sch * 16 + 16) = rv1;
        if (tid < 96) *(LAS f32x4*)(lds + HG_EV + tid * 16) = rev;
        if (c < 65) HG_LOAD(c + 1);
        LBAR();
        {
            const int ti = w >> 1;
#pragma unroll
            for (int e = 0; e < 2; ++e) {
                const int si = 2 * (w & 1) + e;
                f32x4 a = (f32x4){0.f, 0.f, 0.f, 0.f};
                if (si <= ti) {
#pragma unroll
                    for (int ks = 0; ks < 4; ++ks) {
                        const bf16x8 qa = *(const LAS bf16x8*)(lds + HG_QE + (16 * ti + fr) * HG_STR + (32 * ks + 8 * fq) * 2);
                        const bf16x8 kb = *(const LAS bf16x8*)(lds + HG_KE + (16 * si + fr) * HG_STR + (32 * ks + 8 * fq) * 2);
                        a = __builtin_amdgcn_mfma_f32_16x16x32_bf16(qa, kb, a, 0, 0, 0);
                    }
                }
                const int s = 16 * si + fr;
#pragma unroll
                for (int i = 0; i < 4; ++i) { const int t = 16 * ti + 4 * fq + i; const float val = (s <= t) ? a[i] : 0.f;
                    *(LAS unsigned short*)(lds + HG_A1 + t * HG_TSTR + 2 * s) = (unsigned short)(pk2(val, 0.f) & 0xffffu); }
            }
        }
        bf16x8 vf[2];
#pragma unroll
        for (int ks = 0; ks < 2; ++ks) {
            const s16x4 lo = vtr(lds + HG_V + (32 * ks + 8 * fq + trq) * HG_STR + (16 * w + 4 * trp) * 2);
            const s16x4 hi = vtr(lds + HG_V + (32 * ks + 8 * fq + 4 + trq) * HG_STR + (16 * w + 4 * trp) * 2);
            vf[ks] = __builtin_shufflevector(lo, hi, 0, 1, 2, 3, 4, 5, 6, 7);
        }
        bf16x8 sp[4];
#pragma unroll
        for (int a = 0; a < 4; ++a) {
            const f32x4 e0 = *(const LAS f32x4*)(lds + HG_EV + (32 * a + 4 * fq) * 4), e1 = *(const LAS f32x4*)(lds + HG_EV + (32 * a + 16 + 4 * fq) * 4);
            const f32x4 x0 = S[2 * a] * e0, x1 = S[2 * a + 1] * e1;
            const u32x4 pk = (u32x4){pk2(x0[0], x0[1]), pk2(x0[2], x0[3]), pk2(x1[0], x1[1]), pk2(x1[2], x1[3])};
            sp[a] = __builtin_bit_cast(bf16x8, pk);
        }
#pragma unroll
        for (int dt = 0; dt < 8; ++dt) {
            f32x4 acc = (f32x4){0.f, 0.f, 0.f, 0.f};
#pragma unroll
            for (int ks = 0; ks < 2; ++ks) {
                const s16x4 lo = vtr(lds + HG_KE + (32 * ks + 8 * fq + trq) * HG_STR + (16 * dt + 4 * trp) * 2);
                const s16x4 hi = vtr(lds + HG_KE + (32 * ks + 8 * fq + 4 + trq) * HG_STR + (16 * dt + 4 * trp) * 2);
                const bf16x8 kf = __builtin_shufflevector(lo, hi, 0, 1, 2, 3, 4, 5, 6, 7);
                acc = __builtin_amdgcn_mfma_f32_16x16x32_bf16(kf, vf[ks], acc, 0, 0, 0);
            }
            const f32x4 el = *(const LAS f32x4*)(lds + HG_EV + (128 + 16 * dt + 4 * fq) * 4), elm = *(const LAS f32x4*)(lds + HG_EV + (256 + 16 * dt + 4 * fq) * 4);
            S[dt] = S[dt] * el + acc * elm;
        }
        LBAR();
        f32x4 o[4];
#pragma unroll
        for (int tt = 0; tt < 4; ++tt) {
            f32x4 acc = (f32x4){0.f, 0.f, 0.f, 0.f};
#pragma unroll
            for (int ks = 0; ks < 2; ++ks) {
                const bf16x8 af = *(const LAS bf16x8*)(lds + HG_A1 + (16 * tt + fr) * HG_TSTR + (32 * ks + 8 * fq) * 2);
                acc = __builtin_amdgcn_mfma_f32_16x16x32_bf16(af, vf[ks], acc, 0, 0, 0);
            }
#pragma unroll
            for (int a = 0; a < 4; ++a) {
                const s16x4 lo = *(const LAS s16x4*)(lds + HG_QE + (16 * tt + fr) * HG_STR + (32 * a + 4 * fq) * 2);
                const s16x4 hi = *(const LAS s16x4*)(lds + HG_QE + (16 * tt + fr) * HG_STR + (32 * a + 16 + 4 * fq) * 2);
                const bf16x8 qa = __builtin_shufflevector(lo, hi, 0, 1, 2, 3, 4, 5, 6, 7);
                acc = __builtin_amdgcn_mfma_f32_16x16x32_bf16(qa, sp[a], acc, 0, 0, 0);
            }
            o[tt] = acc;
        }
        if (c >= 2) {
#pragma unroll
            for (int tt = 0; tt < 4; ++tt) {
                f32x4 q = o[tt] * o[tt];
#pragma unroll
                for (int sh = 1; sh < 16; sh <<= 1) { q[0] += __shfl_xor(q[0], sh); q[1] += __shfl_xor(q[1], sh); q[2] += __shfl_xor(q[2], sh); q[3] += __shfl_xor(q[3], sh); }
                const int s0 = 64 * c + 16 * tt + 4 * fq - 128;
                if (fr == 0) *(f32x4*)(SSQ + ((size_t)((b * 8 + h) * 8 + w)) * SEQ + s0) = q;
#pragma unroll
                for (int i = 0; i < 4; ++i)
                    OA[((size_t)b * SEQ + s0 + i) * DM + h * 128 + 16 * w + fr] = (bf16_t)(pk2(o[tt][i] * gv, 0.f) & 0xffffu);
            }
        }
    }
#undef HG_LOAD
    __syncthreads();
}

constexpr int AT_SLOT = 65536, AT_VOFF = 32768;
constexpr int AT_X = 0;
__device__ __forceinline__ int crow(int r, int hi) { return (r & 3) + 8 * (r >> 2) + 4 * hi; }
typedef __bf16 bf16x2_t __attribute__((ext_vector_type(2)));
__device__ __forceinline__ unsigned cvtpk_s(float lo, float hi) { f32x2v v = {lo, hi}; bf16x2_t bb = __builtin_convertvector(v, bf16x2_t); return __builtin_bit_cast(unsigned, bb); }
__device__ __forceinline__ float max3f(float a, float b, float c) { return fmaxf(fmaxf(a, b), c); }
constexpr float AT_THR = 8.0f;

__device__ __forceinline__ void attn_unit(ldsp lds, const bf16_t* AQ, const bf16_t* AK, const bf16_t* AV, bf16_t* OB, const float* gB, float lam, int b, int h, int qblk) {
    const int tid = threadIdx.x, lane = tid & 63, w = __builtin_amdgcn_readfirstlane(tid >> 6), comp = w >> 2, qsub = w & 3, r = lane & 31, hi = lane >> 5;
    const int L0 = qblk * 128;
    const size_t rowb = (size_t)(b * 8 + h) * LP;
    const int qL = L0 + 32 * qsub + r;
    int gk[4], gv[4];
    {
        const int l4 = lane >> 4, p16 = lane & 15;
#pragma unroll
        for (int i = 0; i < 4; ++i) { const int row = 16 * w + 4 * i + l4;
            gk[i] = row * 128 + ((p16 ^ (row & 15)) << 3);
            gv[i] = row * 128 + ((p16 ^ ((row & 3) << 2)) << 3); }
    }
#define AT_DMA(j) do { const bf16_t* kb_ = AK + (rowb + 128 * (j)) * 128; const bf16_t* vb_ = AV + (rowb + 128 * (j)) * 128; const int so_ = ((j) & 1) * AT_SLOT + 4 * w * 1024; \
        _Pragma("unroll") for (int i_ = 0; i_ < 4; ++i_) { \
            __builtin_amdgcn_global_load_lds((const unsigned*)(kb_ + gk[i_]), (LAS unsigned*)(lds + so_ + i_ * 1024), 16, 0, 0); \
            __builtin_amdgcn_global_load_lds((const unsigned*)(vb_ + gv[i_]), (LAS unsigned*)(lds + so_ + AT_VOFF + i_ * 1024), 16, 0, 0); } } while (0)
    LBAR();
    if (w >= 6) AT_DMA(0);
    AT_DMA(1);
    bf16x8 qf[4];
    {
        const bf16_t* qp = AQ + (rowb + qL) * 128 + comp * 64 + 8 * hi;
#pragma unroll
        for (int ks = 0; ks < 4; ++ks) qf[ks] = *(const bf16x8*)(qp + 16 * ks);
    }
    f32x16 o[4];
#pragma unroll
    for (int t4 = 0; t4 < 4; ++t4)
#pragma unroll
        for (int i = 0; i < 16; ++i) o[t4][i] = 0.f;
    float mhat = 0.f, lrun = 0.f;
    int kaddr[4], vaddr[4];
    {
        const int q_ = (lane & 15) >> 2, p_ = lane & 3, g1 = (lane >> 4) & 1;
#pragma unroll
        for (int ks = 0; ks < 4; ++ks) kaddr[ks] = r * 256 + (((comp * 8 + 2 * ks + hi) ^ (r & 15)) << 4);
#pragma unroll
        for (int t4 = 0; t4 < 4; ++t4) vaddr[t4] = AT_VOFF + (4 * hi + q_) * 256 + ((((t4 ^ q_) << 2) + g1 * 2 + (p_ >> 1)) << 4) + (p_ & 1) * 8;
    }
    asm volatile("s_waitcnt vmcnt(0)" ::: "memory");
    LBAR();
    {
        f32x16 s3;
#pragma unroll
        for (int i = 0; i < 16; ++i) s3[i] = 0.f;
#pragma unroll
        for (int ks = 0; ks < 4; ++ks) { const bf16x8 kf = *(const LAS bf16x8*)(lds + kaddr[ks] + 3 * 8192); s3 = __builtin_amdgcn_mfma_f32_32x32x16_bf16(kf, qf[ks], s3, 0, 0, 0); }
#pragma unroll
        for (int i = 0; i < 16; ++i) if (96 + crow(i, hi) < PADN) s3[i] = -1e30f;
        float rm = s3[0];
#pragma unroll
        for (int i = 1; i < 16; ++i) rm = fmaxf(rm, s3[i]);
        rm = fmaxf(rm, __shfl_xor(rm, 32));
        mhat = rm;
        float ls = 0.f;
#pragma unroll
        for (int i = 0; i < 16; ++i) { s3[i] = fexp2(s3[i] - rm); ls += s3[i]; }
        lrun = ls;
        u32x4 p0 = (u32x4){cvtpk_s(s3[0], s3[1]), cvtpk_s(s3[2], s3[3]), cvtpk_s(s3[4], s3[5]), cvtpk_s(s3[6], s3[7])};
        u32x4 p1 = (u32x4){cvtpk_s(s3[8], s3[9]), cvtpk_s(s3[10], s3[11]), cvtpk_s(s3[12], s3[13]), cvtpk_s(s3[14], s3[15])};
        const bf16x8 pa0 = __builtin_bit_cast(bf16x8, p0), pa1 = __builtin_bit_cast(bf16x8, p1);
#pragma unroll
        for (int t4 = 0; t4 < 4; ++t4) {
            const s16x4 lo0 = vtr(lds + vaddr[t4] + 96 * 256), hv0 = vtr(lds + vaddr[t4] + 104 * 256), lo1 = vtr(lds + vaddr[t4] + 112 * 256), hv1 = vtr(lds + vaddr[t4] + 120 * 256);
            const bf16x8 vf0 = __builtin_shufflevector(lo0, hv0, 0, 1, 2, 3, 4, 5, 6, 7), vf1 = __builtin_shufflevector(lo1, hv1, 0, 1, 2, 3, 4, 5, 6, 7);
            o[t4] = __builtin_amdgcn_mfma_f32_32x32x16_bf16(vf0, pa0, o[t4], 0, 0, 0);
            o[t4] = __builtin_amdgcn_mfma_f32_32x32x16_bf16(vf1, pa1, o[t4], 0, 0, 0);
        }
    }
    LBAR();
    auto tile = [&](const int j, auto DIAG) __attribute__((always_inline)) {
        constexpr bool diag = decltype(DIAG)::value;
        if (!diag) AT_DMA(j + 1);
        const ldsp sl = lds + (j & 1) * AT_SLOT;
        {
            f32x16 s[4];
            {
                f32x16 negm;
#pragma unroll
                for (int i = 0; i < 16; ++i) negm[i] = -mhat;
#pragma unroll
                for (int ks = 0; ks < 4; ++ks) {
                    bf16x8 kf[4];
#pragma unroll
                    for (int sb = 0; sb < 4; ++sb) kf[sb] = *(const LAS bf16x8*)(sl + kaddr[ks] + sb * 8192);
#pragma unroll
                    for (int sb = 0; sb < 4; ++sb) s[sb] = __builtin_amdgcn_mfma_f32_32x32x16_bf16(kf[sb], qf[ks], ks == 0 ? negm : s[sb], 0, 0, 0);
                }
            }
            if constexpr (diag) {
#pragma unroll
                for (int sb = 0; sb < 4; ++sb)
#pragma unroll
                    for (int i = 0; i < 16; ++i) { const int key = 128 * j + 32 * sb + crow(i, hi); if (key > qL) s[sb][i] = -1e30f; }
            }
            float ma = max3f(s[0][0], s[0][1], s[0][2]), mb = max3f(s[0][3], s[1][0], s[1][1]);
#pragma unroll
            for (int sb = 0; sb < 4; ++sb)
#pragma unroll
                for (int i = 0; i < 16; i += 4) { ma = max3f(ma, s[sb][i], s[sb][i + 1]); mb = max3f(mb, s[sb][i + 2], s[sb][i + 3]); }
            float rm = fmaxf(ma, mb);
            rm = fmaxf(rm, __shfl_xor(rm, 32));
            if (__any(rm > AT_THR)) {
                const float dl = fmaxf(rm, 0.f);
                mhat += dl;
#pragma unroll
                for (int sb = 0; sb < 4; ++sb)
#pragma unroll
                    for (int i = 0; i < 16; ++i) s[sb][i] -= dl;
                const float f = fexp2(-dl);
                lrun *= f;
#pragma unroll
                for (int t4 = 0; t4 < 4; ++t4)
#pragma unroll
                    for (int i = 0; i < 16; ++i) o[t4][i] *= f;
            }
            float ls0 = 0.f, ls1 = 0.f;
#pragma unroll
            for (int sb = 0; sb < 4; ++sb) {
#pragma unroll
                for (int i = 0; i < 16; i += 2) { s[sb][i] = fexp2(s[sb][i]); s[sb][i + 1] = fexp2(s[sb][i + 1]); ls0 += s[sb][i]; ls1 += s[sb][i + 1]; }
                u32x4 p0 = (u32x4){cvtpk_s(s[sb][0], s[sb][1]), cvtpk_s(s[sb][2], s[sb][3]), cvtpk_s(s[sb][4], s[sb][5]), cvtpk_s(s[sb][6], s[sb][7])};
                u32x4 p1 = (u32x4){cvtpk_s(s[sb][8], s[sb][9]), cvtpk_s(s[sb][10], s[sb][11]), cvtpk_s(s[sb][12], s[sb][13]), cvtpk_s(s[sb][14], s[sb][15])};
                const bf16x8 pa0 = __builtin_bit_cast(bf16x8, p0), pa1 = __builtin_bit_cast(bf16x8, p1);
                bf16x8 vf0[4], vf1[4];
#pragma unroll
                for (int t4 = 0; t4 < 4; ++t4) {
                    const s16x4 lo0 = vtr(sl + vaddr[t4] + (32 * sb) * 256);
                    const s16x4 hv0 = vtr(sl + vaddr[t4] + (32 * sb + 8) * 256);
                    const s16x4 lo1 = vtr(sl + vaddr[t4] + (32 * sb + 16) * 256);
                    const s16x4 hv1 = vtr(sl + vaddr[t4] + (32 * sb + 24) * 256);
                    vf0[t4] = __builtin_shufflevector(lo0, hv0, 0, 1, 2, 3, 4, 5, 6, 7);
                    vf1[t4] = __builtin_shufflevector(lo1, hv1, 0, 1, 2, 3, 4, 5, 6, 7);
                }
#pragma unroll
                for (int t4 = 0; t4 < 4; ++t4) o[t4] = __builtin_amdgcn_mfma_f32_32x32x16_bf16(vf0[t4], pa0, o[t4], 0, 0, 0);
#pragma unroll
                for (int t4 = 0; t4 < 4; ++t4) o[t4] = __builtin_amdgcn_mfma_f32_32x32x16_bf16(vf1[t4], pa1, o[t4], 0, 0, 0);
            }
            lrun += ls0 + ls1;
        }
        asm volatile("s_waitcnt vmcnt(0)" ::: "memory");
        LBAR();
    };
    for (int j = 1; j < qblk; ++j) tile(j, std::false_type{});
    tile(qblk, std::true_type{});
#undef AT_DMA
    lrun += __shfl_xor(lrun, 32);
    const float inv = 1.0f / lrun;
    if (comp == 1) {
#pragma unroll
        for (int t4 = 0; t4 < 4; ++t4)
#pragma unroll
            for (int i = 0; i < 16; ++i) *(LAS float*)(lds + AT_X + ((qsub * 64 + t4 * 16 + i) * 64 + lane) * 4) = o[t4][i] * inv;
    }
    LBAR();
    if (comp == 0) {
        float ss = 0.f;
#pragma unroll
        for (int t4 = 0; t4 < 4; ++t4)
#pragma unroll
            for (int i = 0; i < 16; ++i) { const float x2 = *(const LAS float*)(lds + AT_X + ((qsub * 64 + t4 * 16 + i) * 64 + lane) * 4);
                const float v = o[t4][i] * inv - lam * x2; o[t4][i] = v; ss += v * v; }
        ss += __shfl_xor(ss, 32);
        const float rstd = 0.8f / sqrtf(ss * (1.0f / 128.0f) + 1e-6f);
        bf16_t* op = OB + ((size_t)b * SEQ + (qL - 128)) * DM + h * 128;
#pragma unroll
        for (int t4 = 0; t4 < 4; ++t4)
#pragma unroll
            for (int g4 = 0; g4 < 4; ++g4) {
                const int dv = 32 * t4 + 8 * g4 + 4 * hi;
                const f32x4 gg = *(const f32x4*)(gB + dv);
                const u32x2 pk = (u32x2){pk2(o[t4][4 * g4] * rstd * gg[0], o[t4][4 * g4 + 1] * rstd * gg[1]), pk2(o[t4][4 * g4 + 2] * rstd * gg[2], o[t4][4 * g4 + 3] * rstd * gg[3])};
                *(u32x2*)(op + dv) = pk;
            }
    }
}

__device__ __forceinline__ f32x4 meta_dot(const bf16_t* ua, const bf16_t* wb) {
    f32x4 c0 = (f32x4){0.f, 0.f, 0.f, 0.f}, c1 = c0;
#pragma unroll 4
    for (int ks = 0; ks < 32; ks += 2) {
        const bf16x8 a0 = *(const bf16x8*)(ua + 32 * ks), b0 = *(const bf16x8*)(wb + 32 * ks);
        const bf16x8 a1 = *(const bf16x8*)(ua + 32 * ks + 32), b1 = *(const bf16x8*)(wb + 32 * ks + 32);
        c0 = __builtin_amdgcn_mfma_f32_16x16x32_bf16(a0, b0, c0, 0, 0, 0);
        c1 = __builtin_amdgcn_mfma_f32_16x16x32_bf16(a1, b1, c1, 0, 0, 0);
    }
    return c0 + c1;
}
__device__ __forceinline__ void meta_task(const bf16_t* U, const bf16_t* WIN, bf16_t* P, const float* lb, const float* rope, float* EVG, int task, int lane) {
    const int fr = lane & 15, fq = lane >> 4;
    const bf16_t* ua = U + (size_t)(MREAL + fr) * DM + 8 * fq;
    if (task < 64) {
        const int t = task >> 3, uu = task & 7, ch = 16 * uu + fr;
        const f32x4 cq = meta_dot(ua, WIN + (size_t)(256 * t + 16 * uu + fr) * DM + 8 * fq);
        const f32x4 cf = meta_dot(ua, WIN + (size_t)(256 * t + 128 + 16 * uu + fr) * DM + 8 * fq);
        const float lbv = lb[t * 128 + ch];
        float f[4], bc[4], run = 0.f;
#pragma unroll
        for (int i = 0; i < 4; ++i) { f[i] = lbv + (1.0f - lbv) * sigmoidf_(cf[i]); run += __logf(f[i]); bc[i] = run; }
        const float t16 = __shfl_up(run, 16), t32 = __shfl_up(run, 32), t48 = __shfl_up(run, 48);
        const float pre = (fq >= 1 ? t16 : 0.f) + (fq >= 2 ? t32 : 0.f) + (fq >= 3 ? t48 : 0.f);
        const float bl = __shfl(pre + run, 48 + fr);
        unsigned short oq[4], ok[4];
#pragma unroll
        for (int i = 0; i < 4; ++i) {
            const float d = fminf(fmaxf(pre + bc[i], -80.f), 80.f);
            const float e1 = fexp2(d * LOG2E), e2 = __builtin_amdgcn_rcpf(e1);
            oq[i] = (unsigned short)(pk2(cq[i] * e1, 0.f) & 0xffffu); ok[i] = (unsigned short)(pk2((1.0f - f[i]) * e2, 0.f) & 0xffffu);
        }
        const float elv = fexp2(bl * LOG2E);
        for (int b = 0; b < NB; ++b) {
#pragma unroll
            for (int i = 0; i < 4; ++i) { const size_t off = ((size_t)(b * 8 + t) * LP + PADN + 4 * fq + i) * 128 + ch; P[off] = oq[i]; P[PSTRIDE + off] = ok[i]; }
            if (fq == 0) { float* ev = EVG + ((size_t)((b * 8 + t) * 66 + 1)) * 384 + ch; ev[0] = 1.0f; ev[128] = elv; ev[256] = fexp2(fmaxf(bl, -100.f) * LOG2E); }
        }
        return;
    }
    const int n0 = 2048 + 16 * (task - 64), seg = 2 + ((n0 - 2048) >> 10), col = ((n0 - 2048) & 1023) + fr;
    f32x4 c = meta_dot(ua, WIN + (size_t)(n0 + fr) * DM + 8 * fq);
    if ((seg == 3 || seg == 4) && ((n0 & 63) == 0)) {
#pragma unroll
        for (int i = 0; i < 4; ++i) {
            const float p = __shfl_xor(c[i], 8);
            const float* rt = rope + (size_t)(4 * fq + i) * 16;
            const float cs = rt[fr & 7], sn = rt[8 + (fr & 7)];
            c[i] = (fr < 8) ? c[i] * cs - p * sn : c[i] * cs + p * sn;
        }
    }
    if (seg == 3) c = c * QSCALE;
    bf16_t* base = P + (size_t)seg * PSTRIDE + (col & 127);
#pragma unroll
    for (int i = 0; i < 4; ++i) { const unsigned short ob = (unsigned short)(pk2(c[i], 0.f) & 0xffffu);
        for (int b = 0; b < NB; ++b) base[((size_t)(b * 8 + (col >> 7)) * LP + PADN + 4 * fq + i) * 128] = ob; }
}

constexpr size_t WS_XBAR = 896 * 1024;
#define XB_TMO      128
#define XB_XCNT(j)  (256  + 64 * (j))
#define XB_XSUB(j)  (1280 + 64 * (j))
#define XB_XGEN(j)  (2304 + 64 * (j))
#define XB_TOP      3328
#define XB_TOPGEN   3392
#define XCD_BAR_WORDS 3456
#define XB_SPIN_CAP (1u << 18)

__device__ __forceinline__ unsigned xb_ld(unsigned* p)              { return __hip_atomic_load(p, __ATOMIC_RELAXED, __HIP_MEMORY_SCOPE_AGENT); }
__device__ __forceinline__ unsigned xb_add(unsigned* p, unsigned v) { return __hip_atomic_fetch_add(p, v, __ATOMIC_RELAXED, __HIP_MEMORY_SCOPE_AGENT); }
__device__ __forceinline__ unsigned xb_xcc_id() { return (unsigned)__builtin_amdgcn_s_getreg((3 << 11) | 20) & 0xFu; }
#define XB_SPIN(cond, bar) do { unsigned _sp = 0; while (cond) { __builtin_amdgcn_s_sleep(1); \
    if ((++_sp & 255u) == 0u) { if (xb_ld(&(bar)[XB_TMO])) break; if (_sp > XB_SPIN_CAP) { atomicAdd(&(bar)[XB_TMO], 1u); break; } } } } while (0)

struct XcdBarrier {
    unsigned* bar; unsigned x;
    volatile LAS unsigned* st;
};

__device__ __forceinline__ XcdBarrier xcd_barrier_post(unsigned* bar, volatile LAS unsigned* st) {
    XcdBarrier b; b.bar = bar; b.x = xb_xcc_id(); b.st = st;
    if (threadIdx.x == 0) (void)xb_add(&bar[XB_XCNT(b.x)], 1u);
    return b;
}
__device__ __forceinline__ void xcd_barrier_complete(unsigned* bar, unsigned x, unsigned& nloc, unsigned& nx) {
    const unsigned G = gridDim.x * gridDim.y * gridDim.z;
    unsigned sum, cnt, mine, sp = 0u;
    for (;;) {
        sum = 0u; cnt = 0u; mine = 0u;
#pragma unroll
        for (unsigned j = 0; j < 16; ++j) { const unsigned c = xb_ld(&bar[XB_XCNT(j)]); sum += c; cnt += (c > 0u) ? 1u : 0u; mine = (j == x) ? c : mine; }
        if (sum == G) break;
        __builtin_amdgcn_s_sleep(1);
        if ((++sp & 255u) == 0u) { if (xb_ld(&bar[XB_TMO])) break; if (sp > XB_SPIN_CAP) { atomicAdd(&bar[XB_TMO], 1u); break; } }
    }
    nloc = mine > 0u ? mine : 1u; nx = cnt > 0u ? cnt : 1u;
}

__device__ __forceinline__ void xcd_barrier(const XcdBarrier& b) {
    asm volatile("s_waitcnt vmcnt(0)" ::: "memory");
    __syncthreads();
    if (threadIdx.x == 0) {
        unsigned* bar = b.bar;
        __builtin_amdgcn_s_waitcnt(0);
        unsigned nloc = b.st[0], nx = b.st[1];
        if (nloc == 0u) { xcd_barrier_complete(bar, b.x, nloc, nx); b.st[0] = nloc; b.st[1] = nx; }
        const unsigned old = xb_add(&bar[XB_XSUB(b.x)], 1u);
        const unsigned gen = old / nloc;
        if (old + 1u == (gen + 1u) * nloc) {
            __builtin_amdgcn_fence(__ATOMIC_RELEASE, "agent");
            asm volatile("s_waitcnt vmcnt(0)" ::: "memory");
            const unsigned og = xb_add(&bar[XB_TOP], 1u);
            const unsigned tg = og / nx;
            if (og + 1u == (tg + 1u) * nx) xb_add(&bar[XB_TOPGEN], 1u);
            else XB_SPIN(xb_ld(&bar[XB_TOPGEN]) == tg, bar);
            __builtin_amdgcn_fence(__ATOMIC_ACQUIRE, "agent");
            xb_add(&bar[XB_XGEN(b.x)], 1u);
            asm volatile("s_waitcnt vmcnt(0)" ::: "memory");
        } else {
            XB_SPIN(xb_ld(&bar[XB_XGEN(b.x)]) == gen, bar);
            __builtin_amdgcn_fence(__ATOMIC_ACQUIRE, "agent");
            asm volatile("s_waitcnt vmcnt(0)" ::: "memory");
        }
    }
    __syncthreads();
}

#ifndef REPMASK
#define REPMASK 0
#endif
#define NREP(k) ((((REPMASK) >> (k)) & 1) + 1)
struct Args { const float* in[12]; float* out; unsigned char* ws; int ph_lo, ph_hi, flags, pad; };
constexpr int NPH = 7;

__global__ void __launch_bounds__(512, 2) mega_fwd(Args args) {
    extern __shared__ __attribute__((aligned(16))) unsigned char lds_raw[];
    ldsp lds = (ldsp)lds_raw;
    const int tid = threadIdx.x, lane = tid & 63, wave = __builtin_amdgcn_readfirstlane(tid >> 6);
    const int G = gridDim.x, bx = blockIdx.x;
    unsigned char* ws = args.ws;
    const float* x = args.in[0]; const float* meta = args.in[1]; const float* norm_g = args.in[2]; const float* w_in = args.in[3];
    const float* lb_logits = args.in[4]; const float* hg_g = args.in[5]; const float* da_lambda = args.in[6]; const float* da_g = args.in[7];
    const float* w_a = args.in[8]; const float* w_b = args.in[9]; const float* w_o = args.in[10]; const float* final_g = args.in[11];
    unsigned* ctl = (unsigned*)(ws + WS_CTL);
    float* lamp = (float*)(ws + WS_CTL + 1024);
    float* lbt = (float*)(ws + WS_LB);
    float* rope = (float*)(ws + WS_ROPE);
    float* rmsx = (float*)(ws + 512 * 1024);
    float* ginv = (float*)(ws + 768 * 1024);
    bf16_t* WIN = (bf16_t*)(ws + WS_WIN); bf16_t* WA = (bf16_t*)(ws + WS_WA); bf16_t* WB = (bf16_t*)(ws + WS_WB); bf16_t* WO = (bf16_t*)(ws + WS_WO);
    bf16_t* U = (bf16_t*)(ws + WS_U);
    float* EVG = (float*)(ws + WS_EV);
    float* SSQ = (float*)(ws + WS_SSQ);
    bf16_t* P = (bf16_t*)(ws + WS_P);
    bf16_t* OAB = (bf16_t*)args.out;
    const int lo = args.ph_lo, hi = args.ph_hi;
    cg::grid_group grid = cg::this_grid();
    volatile LAS unsigned* bst = (volatile LAS unsigned*)(lds + 131072 + 16);
    if (tid == 0) { bst[0] = 0u; bst[1] = 0u; }
    __syncthreads();
    const XcdBarrier xbar = xcd_barrier_post((unsigned*)(ws + WS_XBAR), bst);
    if (args.flags == 0x7fffffff) grid.sync();
#define IN(k) (lo <= (k) && (k) < hi)
#define SEAM(k) do { if (IN(k) && IN((k) + 1)) xcd_barrier(xbar); } while (0)

    if (IN(0)) for (int rep_ = 0; rep_ < NREP(0); ++rep_) {
        if (rep_) grid.sync();
        const int gw = bx * 8 + wave, NGW = G * 8;
        const int gt = bx * 512 + tid, NGT = G * 512;
        if (bx == 0 && tid < 8) ctl[16 * tid] = 0u;
        if (bx == 0 && tid == 0) {
            float s1 = 0.f, s2 = 0.f;
            for (int i = 0; i < 64; ++i) { s1 += da_lambda[i] * da_lambda[64 + i]; s2 += da_lambda[128 + i] * da_lambda[192 + i]; }
            *lamp = expf(s1) - expf(s2) + 0.2f;
        }
        for (int i = gt; i < 1024; i += NGT) { const float l0 = lb_logits[i], l1 = lb_logits[1024 + i]; lbt[i] = 1.0f / (1.0f + expf(l1 - l0)); ginv[i] = 1.0f / norm_g[i]; }
        for (int i = gt; i < 4112 * 8; i += NGT) { const int pos = i >> 3, j = i & 7;
            const float invf = powf(500000.0f, -(float)j * 0.125f); const float ang = (float)pos * invf;
            float sn, cs; sincos_d(ang, sn, cs); rope[pos * 16 + j] = cs; rope[pos * 16 + 8 + j] = sn; }
        LAS float* scr = (LAS float*)(lds + wave * 16384);
        constexpr int I_IN = 16 * 320, I_SQ = 16 * 32;
        for (int it = gw; it < I_IN + 3 * I_SQ; it += NGW) {
            if (it < I_IN) { const int kb = it / 320, nb = it % 320, n0 = nb * 32, sg = n0 >> 10;
                const int wi = n0 & 1023;
                const int drow = sg == 0 ? ((wi >> 7) * 256 + (wi & 127)) : sg == 1 ? ((wi >> 7) * 256 + 128 + (wi & 127))
                               : (int)((0x9875436210ULL >> (4 * sg)) & 0xFULL) * 1024 + wi;
                p0_transpose_item(w_in, 1024, 10240, WIN, drow, scr, kb * 64, n0, lane); }
            else { const int r = it - I_IN, m = r / I_SQ, q = r % I_SQ, kb = q / 32, nb = q % 32;
                const float* W = m == 0 ? w_a : (m == 1 ? w_b : w_o); bf16_t* WT = m == 0 ? WA : (m == 1 ? WB : WO);
                p0_transpose_item(W, 1024, 1024, WT, nb * 32, scr, kb * 64, nb * 32, lane); }
        }
        for (int m = gw; m < MU; m += NGW) {
            const float* xr = m < MREAL ? x + (size_t)m * DM : (m < MREAL + 16 ? meta + (size_t)(m - MREAL) * DM : nullptr);
            u_row(xr, norm_g, U + (size_t)m * DM, lane, m < MREAL ? rmsx + m : nullptr);
        }
        for (int i = gt; i < 6 * 64 * PADN * 16; i += NGT) { const int run = i / (PADN * 16), q = i % (PADN * 16), a6 = run >> 6, bh = run & 63;
            *(u32x4*)(P + (size_t)a6 * PSTRIDE + (size_t)bh * LP * 128 + (size_t)q * 8) = (u32x4){0u, 0u, 0u, 0u}; }
        __syncthreads();
    }
    SEAM(0);
    if (IN(1)) for (int rep_ = 0; rep_ < NREP(1); ++rep_) {
        if (rep_) grid.sync();
        { const int gw = bx * 8 + wave; if (gw < 320) meta_task(U, WIN, P, lbt, rope, EVG, gw, lane); }
        pg8::Gemm g{U, WIN, MREAL, 6144, 1024}; pg8::StaticOrder S; S.init(MREAL, 6144, G, bx);
        pg8::EpiProj E{P, lbt, rope, EVG};
        pg8::gemm_phase<pg8::EpiProj, pg8::StaticOrder, true, true>(lds, g, S, E);
        __syncthreads();
    }
    SEAM(1);
    if (IN(2)) {
        if (bx < 64 && !(args.flags & 1)) {
            hgrn_seq(lds, P, P + PSTRIDE, P + 2 * PSTRIDE, EVG, OAB, SSQ, hg_g, bx >> 3, bx & 7);
            float* RST = SSQ + (size_t)64 * 8 * SEQ;
            for (int sI = tid; sI < SEQ; sI += 512) { float tot = 0.f;
#pragma unroll
                for (int ww = 0; ww < 8; ++ww) tot += SSQ[((size_t)(bx * 8 + ww)) * SEQ + sI];
                RST[(size_t)bx * SEQ + sI] = __builtin_amdgcn_rsqf(tot * (1.0f / 128.0f) + 1e-6f); }
        }
        const float lam = *lamp;
        LAS unsigned* qslot = (LAS unsigned*)(lds + 131072);
        const int xq = bx & 7;
        if (!(args.flags & 2)) for (;;) {
            __syncthreads();
            if (tid == 0) *qslot = atomicAdd(ctl + 16 * xq, 1u);
            __syncthreads();
            const unsigned idx = *qslot;
            if (idx >= 256u) break;
            const int pass = (int)(idx >> 7), k = (int)(idx & 127u), bhl = k >> 4, qi = k & 15;
            const int qblk = (pass == 0 ? 32 : 16) - qi, bh = 8 * bhl + xq;
            attn_unit(lds, P + 3 * PSTRIDE, P + 4 * PSTRIDE, P + 5 * PSTRIDE, OAB + P3STRIDE, da_g, lam, bh >> 3, bh & 7, qblk);
        }
        __syncthreads();
    }
    SEAM(2);
    if (IN(3)) for (int rep_ = 0; rep_ < NREP(3); ++rep_) {
        if (rep_) grid.sync();
        pg8::Gemm g{U, WIN + (size_t)6144 * 1024, MREAL, 4096, 1024}; pg8::StaticOrder S; S.init(MREAL, 4096, G, bx);
        pg8::EpiGate E{P, OAB, SSQ + (size_t)64 * 8 * SEQ};
        pg8::gemm_phase<pg8::EpiGate, pg8::StaticOrder, true, true>(lds, g, S, E);
        __syncthreads();
    }
    SEAM(3);
    if (IN(4)) for (int rep_ = 0; rep_ < NREP(4); ++rep_) {
        if (rep_) grid.sync();
        bf16_t* Mx = P + 4 * P3STRIDE;
        { pg8::Gemm g{P, WA, 2 * MREAL, 2048, 1024}; pg8::PairOrder S; S.S.init(MREAL, 1024, G, bx);
          pg8::EpiMixPair E{pg8::EpiMix<0>{Mx, P + 2 * P3STRIDE}, pg8::EpiMix<1>{Mx, P + 3 * P3STRIDE}};
          pg8::gemm_phase<pg8::EpiMixPair, pg8::PairOrder, true, true>(lds, g, S, E); }
        __syncthreads();
    }
    SEAM(4);
    if (IN(5)) for (int rep_ = 0; rep_ < NREP(5); ++rep_) {
        if (rep_) grid.sync();
        pg8::Gemm g{P + 4 * P3STRIDE, WO, MREAL, 1024, 1024}; pg8::StaticOrder S; S.init(MREAL, 1024, G, bx);
        pg8::EpiOut E{U, rmsx, ginv, P + 5 * P3STRIDE};
        pg8::gemm_phase<pg8::EpiOut, pg8::StaticOrder, true, true>(lds, g, S, E);
        __syncthreads();
    }
    SEAM(5);
    if (IN(6)) {
        const int gw = bx * 8 + wave, NGW = G * 8;
        const bf16_t* H16 = P + 5 * P3STRIDE;
        f32x4 g0[2], g1[2];
#pragma unroll
        for (int j = 0; j < 2; ++j) { g0[j] = *(const f32x4*)(final_g + j * 512 + lane * 8); g1[j] = *(const f32x4*)(final_g + j * 512 + lane * 8 + 4); }
        for (int m = gw; m < MREAL; m += NGW) {
            const bf16_t* hrow = H16 + (size_t)m * DM; float* orow = args.out + (size_t)m * DM;
            float v[2][8]; float s = 0.f;
#pragma unroll
            for (int j = 0; j < 2; ++j) { const u32x4 hv = *(const u32x4*)(hrow + j * 512 + lane * 8);
                v[j][0] = bflo(hv.x); v[j][1] = bfhi(hv.x); v[j][2] = bflo(hv.y); v[j][3] = bfhi(hv.y); v[j][4] = bflo(hv.z); v[j][5] = bfhi(hv.z); v[j][6] = bflo(hv.w); v[j][7] = bfhi(hv.w);
#pragma unroll
                for (int i = 0; i < 8; ++i) s += v[j][i] * v[j][i]; }
            const float rstd = 1.0f / sqrtf(wave_sum(s) * (1.0f / DM) + 1e-6f);
#pragma unroll
            for (int j = 0; j < 2; ++j) {
                *(f32x4*)(orow + j * 512 + lane * 8) = (f32x4){v[j][0] * rstd * g0[j][0], v[j][1] * rstd * g0[j][1], v[j][2] * rstd * g0[j][2], v[j][3] * rstd * g0[j][3]};
                *(f32x4*)(orow + j * 512 + lane * 8 + 4) = (f32x4){v[j][4] * rstd * g1[j][0], v[j][5] * rstd * g1[j][1], v[j][6] * rstd * g1[j][2], v[j][7] * rstd * g1[j][3]};
            }
        }
    }
#undef IN
#undef SEAM
}

#ifndef MK_LAUNCHES
#define MK_LAUNCHES 1
#endif

extern "C" void kernel_launch(void* const* d_in, const int* in_sizes, int n_in, void* d_out, int out_size, void* d_ws, size_t ws_size, hipStream_t stream) {
    static int grid = 0;
    if (grid == 0) {
        if (n_in != 12 || out_size != MREAL * DM || ws_size < WS_NEED) { fprintf(stderr, "kernel_launch: unexpected shapes (n_in %d out %d ws %zu need %zu)\n", n_in, out_size, ws_size, (size_t)WS_NEED); grid = -1; return; }
        int dev = 0, cus = 0, per_cu = 0;
        hipGetDevice(&dev); hipDeviceGetAttribute(&cus, hipDeviceAttributeMultiprocessorCount, dev);
        if (hipFuncSetAttribute((const void*)mega_fwd, hipFuncAttributeMaxDynamicSharedMemorySize, LDS_BYTES) != hipSuccess) { fprintf(stderr, "kernel_launch: hipFuncSetAttribute failed\n"); grid = -1; return; }
        hipOccupancyMaxActiveBlocksPerMultiprocessor(&per_cu, (const void*)mega_fwd, 512, LDS_BYTES);
        (void)hipGetLastError();
        if (per_cu < 1) per_cu = 1;
        grid = cus;
        fprintf(stderr, "kernel_launch: cus %d per_cu %d grid %d\n", cus, per_cu, grid);
    }
    if (grid < 0) return;
    Args a{};
    for (int i = 0; i < 12; ++i) a.in[i] = (const float*)d_in[i];
    a.out = (float*)d_out; a.ws = (unsigned char*)d_ws;
#if MK_LAUNCHES == 1
    void* kargs[] = {&a};
#ifndef MK_PROBE
#define MK_PROBE 0
#endif
#if MK_PROBE == 0
    a.ph_lo = 0; a.ph_hi = NPH;
    (void)hipMemsetAsync((char*)d_ws + WS_XBAR, 0, 16384, stream);
    hipError_t e = hipLaunchCooperativeKernel((const void*)mega_fwd, dim3(grid), dim3(512), kargs, LDS_BYTES, stream);
    if (e != hipSuccess) fprintf(stderr, "kernel_launch: cooperative launch failed: %s (grid %d)\n", hipGetErrorString(e), grid);
#else
    a.ph_lo = 0; a.ph_hi = MK_PROBE_PH + 1; a.flags = 0;
    (void)hipMemsetAsync((char*)d_ws + WS_XBAR, 0, 16384, stream);
    (void)hipLaunchCooperativeKernel((const void*)mega_fwd, dim3(grid), dim3(512), kargs, LDS_BYTES, stream);
    (void)hipMemsetAsync(d_ws, 0, 512, stream);
    (void)hipMemsetAsync((char*)d_ws + WS_XBAR, 0, 16384, stream);
    a.ph_lo = MK_PROBE_PH; a.ph_hi = MK_PROBE_PH + 1; a.flags = MK_PROBE_FLAGS;
    (void)hipLaunchCooperativeKernel((const void*)mega_fwd, dim3(grid), dim3(512), kargs, LDS_BYTES, stream);
    a.ph_lo = MK_PROBE_PH + 1; a.ph_hi = NPH; a.flags = 0;
    (void)hipMemsetAsync((char*)d_ws + WS_XBAR, 0, 16384, stream);
    (void)hipLaunchCooperativeKernel((const void*)mega_fwd, dim3(grid), dim3(512), kargs, LDS_BYTES, stream);
#endif
#else
    for (int p = 0; p < NPH; ++p) { a.ph_lo = p; a.ph_hi = p + 1; hipLaunchKernelGGL(mega_fwd, dim3(grid), dim3(512), LDS_BYTES, stream, a); }
#endif
}
```

```cpp
#include <hip/hip_runtime.h>
#include <hip/hip_cooperative_groups.h>
#include <cstdio>
#include <cstdint>
#include <type_traits>
namespace cg = cooperative_groups;
namespace pg8 {
#define PG8_LAS __attribute__((address_space(3)))
typedef unsigned short bf16_t;
typedef short bf16x8 __attribute__((ext_vector_type(8)));
typedef float f32x4 __attribute__((ext_vector_type(4)));
typedef unsigned u32x4 __attribute__((ext_vector_type(4)));
constexpr int BM = 256, BK = 64, HALF = 128, HTB = HALF * BK * 2  , STAGE_BYTES = 8 * HTB, NXCD = 8, WGM = 8;

__host__ __device__ __forceinline__ int lds_byte(int r, int c) { const int st = (r >> 4) * 2 + (c >> 5), rr = r & 15, cc = c & 31, ob = rr * 64 + cc * 2; return st * 1024 + (ob ^ (((ob >> 9) & 1) << 5)); }
__host__ __device__ __forceinline__ void stage_rc(int b, int& R, int& C) { const int st = b / 1024, sb = b % 1024, swz = sb ^ (((sb >> 9) & 1) << 5); R = (st >> 1) * 16 + swz / 64; C = (st & 1) * 32 + (swz % 64) / 2; }
__host__ __device__ __forceinline__ int perm32(int rho) { const int n = rho >> 4, i = rho & 15; return 8 * (i >> 2) + 4 * n + (i & 3); }

struct Unit { int pm, pn; };
struct Gemm { const bf16_t* A; const bf16_t* Bt; int M, N, K; };

struct StaticOrder {
    int nM, nN, nwg, G, c;
    __host__ __device__ void init(int M, int N, int G_, int c_) { nM = M / BM; nN = N / BM; nwg = nM * nN; G = G_; c = c_; }
    __host__ __device__ bool next(int i, Unit& u) const {
        const long L = (long)i * G + c; if (L >= nwg) return false;
        int wgid = (int)L; { const int q = nwg / NXCD, r = nwg % NXCD, xcd = wgid % NXCD, off = wgid / NXCD; wgid = (xcd < r ? xcd * (q + 1) : r * (q + 1) + (xcd - r) * q) + off; }
        const int nig = WGM * nN, gid = wgid / nig, fm = gid * WGM, gsz = (nM - fm) < WGM ? (nM - fm) : WGM;
        u.pm = fm + ((wgid % nig) % gsz); u.pn = (wgid % nig) / gsz; return true;
    }
    __device__ __forceinline__ void a_ready(const Unit&) const {}
    __device__ __forceinline__ void done(const Unit&) const {}
};

__device__ __forceinline__ unsigned cvt_pk_bf16(float lo, float hi) { unsigned r; asm volatile("v_cvt_pk_bf16_f32 %0, %1, %2" : "=v"(r) : "v"(lo), "v"(hi)); return r; }
typedef float f32x2 __attribute__((ext_vector_type(2)));
template <class Epi, class Sched, bool ALIGN_EPI = false, bool SP2 = false>
__device__ __forceinline__ void gemm_phase(PG8_LAS unsigned char* lds, const Gemm g, const Sched& S, const Epi& E) {
    const int tid = threadIdx.x, wid = __builtin_amdgcn_readfirstlane(tid >> 6), lane = tid & 63, wr = wid >> 2, wc = wid & 3, fr = lane & 15, fq = lane >> 4;
    const int K = g.K, nt = K / BK;
    unsigned voffA[2], voffB[2];
#pragma unroll
    for (int i = 0; i < 2; ++i) { int R, C; stage_rc(tid * 16 + i * 8192, R, C); const int Rb = Epi::PERM ? ((R & ~31) + perm32(R & 31)) : R;
        voffA[i] = (unsigned)(R * K + C) * 2u; voffB[i] = (unsigned)(Rb * K + C) * 2u; }
    const size_t kstep = (size_t)(BK * 2);
    const size_t hstep = (size_t)HALF * K * 2;
    const size_t tstep = 2 * hstep;
    const unsigned ldsw = (unsigned)wid * 1024u;
    const int aoff = lds_byte(wr * 64 + fr, fq * 8), boff = lds_byte(wc * 32 + fr, fq * 8);
#define PG8_SA(b, h) (((b) * 2 + (h)) * HTB)
#define PG8_SB(b, h) ((4 + (b) * 2 + (h)) * HTB)
#define PG8_STAGE(bufoff, gbase, voff) do { _Pragma("unroll") for (int _i = 0; _i < 2; ++_i) \
        __builtin_amdgcn_global_load_lds((const unsigned*)((const char*)(gbase) + (voff)[_i]), (PG8_LAS unsigned*)(lds + (bufoff) + ldsw + _i * 8192), 16, 0, 0); } while (0)
#define PG8_LDA(dst, b, h) do { _Pragma("unroll") for (int m = 0; m < 4; ++m) _Pragma("unroll") for (int k = 0; k < 2; ++k) dst[m][k] = *(const PG8_LAS bf16x8*)(lds + PG8_SA(b, h) + aoff + m * 2048 + k * 1024); } while (0)
#define PG8_LDB(dst, b, h) do { _Pragma("unroll") for (int n = 0; n < 2; ++n) _Pragma("unroll") for (int k = 0; k < 2; ++k) dst[n][k] = *(const PG8_LAS bf16x8*)(lds + PG8_SB(b, h) + boff + n * 2048 + k * 1024); } while (0)
#define PG8_MMA(ai, bj, At, Bt) do { __builtin_amdgcn_s_setprio(1); _Pragma("unroll") for (int m = 0; m < 4; ++m) _Pragma("unroll") for (int n = 0; n < 2; ++n) _Pragma("unroll") for (int k = 0; k < 2; ++k) \
        acc[ai][bj][m][n] = __builtin_amdgcn_mfma_f32_16x16x32_bf16(Bt[n][k], At[m][k], acc[ai][bj][m][n], 0, 0, 0); __builtin_amdgcn_s_setprio(0); } while (0)
#define PG8_WAIT_V(n) asm volatile("s_waitcnt vmcnt(" #n ")" ::: "memory")
#define PG8_WAIT_L(n) asm volatile("s_waitcnt lgkmcnt(" #n ")" ::: "memory")
#define PG8_BAR __builtin_amdgcn_s_barrier()
#define PG8_SCHED __builtin_amdgcn_sched_barrier(0)
    Unit cur, nxt; int ui = 0;
    if (!S.next(0, cur)) return;
    f32x4 acc[2][2][4][2];
#pragma unroll
    for (int a = 0; a < 2; ++a)
#pragma unroll
        for (int b = 0; b < 2; ++b)
#pragma unroll
            for (int m = 0; m < 4; ++m)
#pragma unroll
                for (int n = 0; n < 2; ++n) acc[a][b][m][n] = (f32x4){0.f, 0.f, 0.f, 0.f};
    bf16x8 At[4][2], B0[2][2], B1[2][2];
    const char* cA = (const char*)g.A + (size_t)cur.pm * tstep; const char* cB = (const char*)g.Bt + (size_t)cur.pn * tstep;
    S.a_ready(cur);
    if constexpr (SP2) {
        PG8_STAGE(PG8_SB(0, 0), cB, voffB); PG8_STAGE(PG8_SB(0, 1), cB + hstep, voffB); PG8_STAGE(PG8_SA(0, 0), cA, voffA); PG8_STAGE(PG8_SA(0, 1), cA + hstep, voffA);
        if (wr == 1) PG8_BAR;
        PG8_WAIT_V(2); PG8_BAR;
        PG8_STAGE(PG8_SB(1, 0), cB + kstep, voffB); PG8_STAGE(PG8_SA(1, 0), cA + kstep, voffA); PG8_STAGE(PG8_SB(1, 1), cB + hstep + kstep, voffB);
        PG8_WAIT_V(6); PG8_BAR;
    } else {
        PG8_STAGE(PG8_SB(0, 0), cB, voffB); PG8_STAGE(PG8_SA(0, 0), cA, voffA); PG8_STAGE(PG8_SB(0, 1), cB + hstep, voffB); PG8_STAGE(PG8_SA(0, 1), cA + hstep, voffA);
        if (wr == 1) PG8_BAR;
        PG8_WAIT_V(4); PG8_BAR;
        PG8_STAGE(PG8_SB(1, 0), cB + kstep, voffB); PG8_STAGE(PG8_SA(1, 0), cA + kstep, voffA); PG8_STAGE(PG8_SB(1, 1), cB + hstep + kstep, voffB);
        PG8_WAIT_V(6); PG8_BAR;
    }
    for (;;) {
        const bool has_next = S.next(ui + 1, nxt);
        const char* nA = has_next ? (const char*)g.A + (size_t)nxt.pm * tstep : cA; const char* nB = has_next ? (const char*)g.Bt + (size_t)nxt.pn * tstep : cB;
        for (int t = 0; t < nt; t += 2) {
            const bool last = (t == nt - 2);
            const char* a1 = cA + (size_t)(t + 1) * kstep;
            const char* a2 = last ? nA : cA + (size_t)(t + 2) * kstep; const char* b2 = last ? nB : cB + (size_t)(t + 2) * kstep;
            const char* a3 = a2 + kstep; const char* b3 = b2 + kstep;
            if (last && has_next) S.a_ready(nxt);
            if constexpr (SP2) {
            PG8_LDB(B0, 0, 0); PG8_LDB(B1, 0, 1); PG8_SCHED; PG8_LDA(At, 0, 0); PG8_STAGE(PG8_SA(1, 1), a1 + hstep, voffA);
            PG8_WAIT_V(8); PG8_WAIT_L(0); PG8_BAR; PG8_MMA(0, 0, At, B0); PG8_MMA(0, 1, At, B1); PG8_BAR; PG8_SCHED;
            PG8_LDA(At, 0, 1); PG8_STAGE(PG8_SB(0, 0), b2, voffB); PG8_STAGE(PG8_SB(0, 1), b2 + hstep, voffB); PG8_STAGE(PG8_SA(0, 0), a2, voffA);
            PG8_WAIT_V(8); PG8_WAIT_L(0); PG8_BAR; PG8_MMA(1, 0, At, B0); PG8_MMA(1, 1, At, B1); PG8_BAR; PG8_SCHED;
            PG8_LDB(B0, 1, 0); PG8_LDB(B1, 1, 1); PG8_SCHED; PG8_LDA(At, 1, 0); PG8_STAGE(PG8_SA(0, 1), a2 + hstep, voffA);
            PG8_WAIT_V(8); PG8_WAIT_L(0); PG8_BAR; PG8_MMA(0, 0, At, B0); PG8_MMA(0, 1, At, B1); PG8_BAR; PG8_SCHED;
            PG8_LDA(At, 1, 1); PG8_STAGE(PG8_SB(1, 0), b3, voffB); PG8_STAGE(PG8_SB(1, 1), b3 + hstep, voffB); PG8_STAGE(PG8_SA(1, 0), a3, voffA);
            PG8_WAIT_V(8); PG8_WAIT_L(0); PG8_BAR; PG8_MMA(1, 0, At, B0); PG8_MMA(1, 1, At, B1); PG8_BAR; PG8_SCHED;
            } else {
            PG8_LDB(B0, 0, 0); PG8_SCHED; PG8_LDA(At, 0, 0); PG8_STAGE(PG8_SA(1, 1), a1 + hstep, voffA);
            PG8_WAIT_L(8); PG8_BAR; PG8_WAIT_L(0); PG8_MMA(0, 0, At, B0); PG8_BAR; PG8_SCHED;
            PG8_LDB(B1, 0, 1); PG8_STAGE(PG8_SB(0, 0), b2, voffB);
            PG8_BAR; PG8_WAIT_L(0); PG8_MMA(0, 1, At, B1); PG8_BAR;
            PG8_LDA(At, 0, 1); PG8_STAGE(PG8_SA(0, 0), a2, voffA);
            PG8_BAR; PG8_WAIT_L(0); PG8_MMA(1, 0, At, B0); PG8_BAR; PG8_SCHED;
            PG8_STAGE(PG8_SB(0, 1), b2 + hstep, voffB);
            PG8_WAIT_V(6); PG8_BAR; PG8_MMA(1, 1, At, B1); PG8_BAR;
            PG8_LDB(B0, 1, 0); PG8_SCHED; PG8_LDA(At, 1, 0); PG8_STAGE(PG8_SA(0, 1), a2 + hstep, voffA);
            PG8_WAIT_L(8); PG8_BAR; PG8_WAIT_L(0); PG8_MMA(0, 0, At, B0); PG8_BAR; PG8_SCHED;
            PG8_LDB(B1, 1, 1); PG8_STAGE(PG8_SB(1, 0), b3, voffB);
            PG8_BAR; PG8_WAIT_L(0); PG8_MMA(0, 1, At, B1); PG8_BAR;
            PG8_LDA(At, 1, 1); PG8_STAGE(PG8_SA(1, 0), a3, voffA);
            PG8_BAR; PG8_WAIT_L(0); PG8_MMA(1, 0, At, B0); PG8_BAR; PG8_SCHED;
            PG8_STAGE(PG8_SB(1, 1), b3 + hstep, voffB);
            PG8_WAIT_V(6); PG8_BAR; PG8_MMA(1, 1, At, B1); PG8_BAR;
            }
        }
        if constexpr (ALIGN_EPI) { if (wr == 0) PG8_BAR; }
        if constexpr (!Epi::AFTER_DRAIN) { E(acc, cur, wr, wc, fr, fq); S.done(cur); }
        if (!has_next) break;
#pragma unroll
        for (int a = 0; a < 2; ++a)
#pragma unroll
            for (int b = 0; b < 2; ++b)
#pragma unroll
                for (int m = 0; m < 4; ++m)
#pragma unroll
                    for (int n = 0; n < 2; ++n) acc[a][b][m][n] = (f32x4){0.f, 0.f, 0.f, 0.f};
        cur = nxt; cA = nA; cB = nB; ++ui;
        if constexpr (ALIGN_EPI) { if (wr == 1) PG8_BAR; }
    }
    PG8_WAIT_V(0);
    if constexpr (!ALIGN_EPI) { if (wr == 0) PG8_BAR; }
    PG8_BAR;
    if constexpr (Epi::AFTER_DRAIN) { E.fused(acc, cur, wr, wc, fr, fq, lds, wid, lane); S.done(cur); }
#undef PG8_SA
#undef PG8_SB
#undef PG8_STAGE
#undef PG8_LDA
#undef PG8_LDB
#undef PG8_MMA
#undef PG8_WAIT_V
#undef PG8_WAIT_L
#undef PG8_BAR
#undef PG8_SCHED
}
}

#define LAS __attribute__((address_space(3)))
typedef unsigned short bf16_t;
typedef short bf16x8 __attribute__((ext_vector_type(8)));
typedef short s16x4 __attribute__((ext_vector_type(4)));
typedef float f32x4 __attribute__((ext_vector_type(4)));
typedef float f32x2v __attribute__((ext_vector_type(2)));
typedef float f32x16 __attribute__((ext_vector_type(16)));
typedef unsigned u32x4 __attribute__((ext_vector_type(4)));
typedef unsigned u32x2 __attribute__((ext_vector_type(2)));
typedef LAS unsigned char* ldsp;

constexpr int NB = 8, SEQ = 4096, DM = 1024, LP = 4224, PADN = 112;
constexpr int MREAL = NB * SEQ;
constexpr int MU = 33024;
constexpr size_t MiB = 1u << 20;
constexpr size_t WS_CTL = 0;
constexpr size_t WS_LB = 4096;
constexpr size_t WS_ROPE = 8192;
constexpr size_t WS_WIN = 1 * MiB;
constexpr size_t WS_WA = 21 * MiB, WS_WB = 23 * MiB, WS_WO = 25 * MiB;
constexpr size_t WS_U = 27 * MiB;
constexpr size_t WS_P = 92 * MiB;
constexpr size_t PSTRIDE = (size_t)NB * LP * DM;
constexpr size_t P3STRIDE = (size_t)MREAL * DM;
constexpr size_t WS_SSQ = 496 * MiB;
constexpr size_t WS_NEED = 506 * MiB;
constexpr float LOG2E = 1.4426950408889634f;
constexpr float QSCALE = 0.125f * LOG2E;
constexpr int LDS_BYTES = 131072 + 1024;

#define LBAR() do { asm volatile("s_waitcnt lgkmcnt(0)" ::: "memory"); __builtin_amdgcn_s_barrier(); asm volatile("" ::: "memory"); } while (0)
__device__ __forceinline__ float wave_sum(float v) {
#pragma unroll
    for (int o = 1; o < 64; o <<= 1) v += __shfl_xor(v, o);
    return v;
}
__device__ __forceinline__ unsigned pk2(float lo, float hi) { return pg8::cvt_pk_bf16(lo, hi); }
__device__ __forceinline__ float bflo(unsigned u) { return __builtin_bit_cast(float, u << 16); }
__device__ __forceinline__ float bfhi(unsigned u) { return __builtin_bit_cast(float, u & 0xffff0000u); }
__device__ __forceinline__ float h2f(unsigned short h) { return (float)__builtin_bit_cast(_Float16, h); }
__device__ __forceinline__ unsigned short f2h(float f) { return __builtin_bit_cast(unsigned short, (_Float16)f); }
__device__ __forceinline__ float fexp2(float x) { return __builtin_amdgcn_exp2f(x); }
__device__ __forceinline__ float sigmoidf_(float x) { return __builtin_amdgcn_rcpf(1.0f + fexp2(-x * LOG2E)); }

namespace pg8 {
template <int N> __device__ __forceinline__ float row_shr(float v) {
    return __builtin_bit_cast(float, __builtin_amdgcn_update_dpp(0, __builtin_bit_cast(int, v), 0x110 + N, 0xf, 0xf, true));
}
template <int N> __device__ __forceinline__ float row_shr1(float v) {
    return __builtin_bit_cast(float, __builtin_amdgcn_update_dpp(0x3f800000, __builtin_bit_cast(int, v), 0x110 + N, 0xf, 0xf, false));
}
struct EpiProj {
    static constexpr bool PERM = true, AFTER_DRAIN = false;
    bf16_t* P; const float* lb; const float* rope; float* EVG;
    __device__ __forceinline__ void operator()(const f32x4 (&acc)[2][2][4][2], const Unit& u, int wr, int wc, int fr, int fq) const {
        const int lane = fr + 16 * fq;
        if (u.pn < 8) {
            const int head = u.pn, ch0 = 32 * wc + 8 * fq;
            const f32x4 lb0 = *(const f32x4*)(lb + head * 128 + ch0), lb1 = *(const f32x4*)(lb + head * 128 + ch0 + 4);
#pragma unroll
            for (int ai = 0; ai < 2; ++ai) {
                const int rp0 = u.pm * BM + ai * HALF + wr * 64;
                const int bb = rp0 >> 12, s0 = rp0 & 4095, cidx = 2 + (s0 >> 6);
                unsigned qpk[4][4], kpk[4][4]; float qev[4], kev[4];
                float emid[8], el[8], elm[8];
#pragma unroll
                for (int e = 0; e < 8; ++e) {
                    const float lbv = e < 4 ? lb0[e] : lb1[e - 4];
                    float f[4], pcs[4], carry = 1.f, pref = 1.f;
#pragma unroll
                    for (int m = 0; m < 4; ++m) {
                        f[m] = lbv + (1.0f - lbv) * sigmoidf_(acc[ai][1][m][e >> 2][e & 3]);
                        float v = f[m];
                        v *= row_shr1<1>(v); v *= row_shr1<2>(v); v *= row_shr1<4>(v); v *= row_shr1<8>(v);
                        v = fmaxf(v * carry, 1e-36f); pcs[m] = v;
                        carry = __shfl(v, (lane & 48) | 15);
                        if (m == 1) pref = carry;
                    }
                    const float pbl = carry, rpref = __builtin_amdgcn_rcpf(pref);
                    emid[e] = pref; el[e] = pbl; elm[e] = pbl * rpref;
#pragma unroll
                    for (int m = 0; m < 4; ++m) {
                        const float rp_ = __builtin_amdgcn_rcpf(pcs[m]);
                        const float e1 = fminf(pcs[m] * rpref, 5.5e34f), e2 = fminf(pref * rp_, 5.5e34f);
                        const float qe = acc[ai][0][m][e >> 2][e & 3] * e1, ke = (1.0f - f[m]) * e2;
                        if (e & 1) { qpk[m][e >> 1] = cvt_pk_bf16(qev[m], qe); kpk[m][e >> 1] = cvt_pk_bf16(kev[m], ke); }
                        else { qev[m] = qe; kev[m] = ke; }
                    }
                }
#pragma unroll
                for (int m = 0; m < 4; ++m) {
                    const size_t off = ((size_t)(bb * 8 + head) * LP + 128 + s0 + m * 16 + fr) * 128 + ch0;
                    *(u32x4*)(P + off) = (u32x4){qpk[m][0], qpk[m][1], qpk[m][2], qpk[m][3]};
                    *(u32x4*)(P + PSTRIDE + off) = (u32x4){kpk[m][0], kpk[m][1], kpk[m][2], kpk[m][3]};
                }
                if (fr == 15) {
                    float* ev = EVG + ((size_t)((bb * 8 + head) * 66 + cidx)) * 384 + ch0;
                    *(f32x4*)(ev) = (f32x4){emid[0], emid[1], emid[2], emid[3]}; *(f32x4*)(ev + 4) = (f32x4){emid[4], emid[5], emid[6], emid[7]};
                    *(f32x4*)(ev + 128) = (f32x4){el[0], el[1], el[2], el[3]}; *(f32x4*)(ev + 132) = (f32x4){el[4], el[5], el[6], el[7]};
                    *(f32x4*)(ev + 256) = (f32x4){elm[0], elm[1], elm[2], elm[3]}; *(f32x4*)(ev + 260) = (f32x4){elm[4], elm[5], elm[6], elm[7]};
                }
            }
            return;
        }
        const int seg = 2 + ((u.pn - 8) >> 2), cseg = ((u.pn - 8) & 3) * BM;
        bf16_t* base = P + (size_t)seg * PSTRIDE;
        const bool ropewave = ((seg == 3) || (seg == 4)) && ((wc & 1) == 0);
#pragma unroll
        for (int ai = 0; ai < 2; ++ai)
#pragma unroll
            for (int m = 0; m < 4; ++m) {
                const int rp = u.pm * BM + ai * HALF + wr * 64 + m * 16 + fr;
                const int bb = rp >> 12, s = rp & 4095;
                const int pos = 16 + s;
#pragma unroll
                for (int bj = 0; bj < 2; ++bj) {
                    const int c0 = cseg + bj * HALF + wc * 32 + 8 * fq;
                    float x[8];
#pragma unroll
                    for (int i = 0; i < 4; ++i) { x[i] = acc[ai][bj][m][0][i]; x[4 + i] = acc[ai][bj][m][1][i]; }
                    if (ropewave) {
                        float p[8];
#pragma unroll
                        for (int i = 0; i < 8; ++i) p[i] = __shfl_xor(x[i], 16);
                        if (fq < 2) {
                            const float* rt = rope + (size_t)pos * 16;
                            const f32x4 c0v = *(const f32x4*)(rt), c1v = *(const f32x4*)(rt + 4), s0v = *(const f32x4*)(rt + 8), s1v = *(const f32x4*)(rt + 12);
                            const float sg = fq == 0 ? -1.0f : 1.0f;
#pragma unroll
                            for (int i = 0; i < 8; ++i) { const float cs = i < 4 ? c0v[i] : c1v[i - 4], sn = i < 4 ? s0v[i] : s1v[i - 4];
                                x[i] = x[i] * cs + sg * p[i] * sn; }
                        }
                    }
                    if (seg == 3) {
#pragma unroll
                        for (int i = 0; i < 8; ++i) x[i] *= QSCALE;
                    }
                    u32x4 w; w.x = cvt_pk_bf16(x[0], x[1]); w.y = cvt_pk_bf16(x[2], x[3]); w.z = cvt_pk_bf16(x[4], x[5]); w.w = cvt_pk_bf16(x[6], x[7]);
                    *(u32x4*)(base + ((size_t)(bb * 8 + (c0 >> 7)) * LP + 128 + s) * 128 + (c0 & 127)) = w;
                }
            }
    }
};
struct EpiGate {
    static constexpr bool PERM = true, AFTER_DRAIN = false;
    bf16_t* T; const bf16_t* OAB; const float* RST;
    __device__ __forceinline__ void operator()(const f32x4 (&acc)[2][2][4][2], const Unit& u, int wr, int wc, int fr, int fq) const {
        const int colt = u.pn * BM, seg = colt >> 10, cseg = colt & 1023;
        bf16_t* base = T + (size_t)seg * P3STRIDE;
        const bf16_t* ob = OAB + (size_t)(seg & 1) * P3STRIDE;
#pragma unroll
        for (int ai = 0; ai < 2; ++ai) {
            u32x4 ov[4][2]; float rn[4][2];
            if (seg < 2) {
#pragma unroll
                for (int m = 0; m < 4; ++m)
#pragma unroll
                    for (int bj = 0; bj < 2; ++bj) {
                        const int rp = u.pm * BM + ai * HALF + wr * 64 + m * 16 + fr, c0 = cseg + bj * HALF + wc * 32 + 8 * fq;
                        ov[m][bj] = *(const u32x4*)(ob + (size_t)rp * DM + c0);
                        rn[m][bj] = seg == 0 ? RST[(size_t)((rp >> 12) * 8 + (c0 >> 7)) * SEQ + (rp & 4095)] : 1.0f;
                    }
            }
#pragma unroll
            for (int m = 0; m < 4; ++m) {
                const int rp = u.pm * BM + ai * HALF + wr * 64 + m * 16 + fr;
#pragma unroll
                for (int bj = 0; bj < 2; ++bj) {
                    const int c0 = cseg + bj * HALF + wc * 32 + 8 * fq;
                    const size_t off = (size_t)rp * DM + c0;
                    float x[8];
#pragma unroll
                    for (int i = 0; i < 4; ++i) { x[i] = acc[ai][bj][m][0][i]; x[4 + i] = acc[ai][bj][m][1][i]; }
                    if (seg < 2) {
                        const u32x4 o = ov[m][bj];
                        const float ovv[8] = {bflo(o.x), bfhi(o.x), bflo(o.y), bfhi(o.y), bflo(o.z), bfhi(o.z), bflo(o.w), bfhi(o.w)};
#pragma unroll
                        for (int i = 0; i < 8; ++i) x[i] = x[i] * sigmoidf_(x[i]) * ovv[i] * rn[m][bj];
                    } else {
#pragma unroll
                        for (int i = 0; i < 8; ++i) x[i] = sigmoidf_(x[i]);
                    }
                    u32x4 w; w.x = cvt_pk_bf16(x[0], x[1]); w.y = cvt_pk_bf16(x[2], x[3]); w.z = cvt_pk_bf16(x[4], x[5]); w.w = cvt_pk_bf16(x[6], x[7]);
                    *(u32x4*)(base + off) = w;
                }
            }
        }
    }
};
template <int STEP> struct EpiMix {
    static constexpr bool PERM = true, AFTER_DRAIN = false;
    bf16_t* M; const bf16_t* SG;
    __device__ __forceinline__ void operator()(const f32x4 (&acc)[2][2][4][2], const Unit& u, int wr, int wc, int fr, int fq) const {
        const int colt = u.pn * BM;
#pragma unroll
        for (int ai = 0; ai < 2; ++ai) {
            u32x4 gq[4][2], pq[4][2];
#pragma unroll
            for (int m = 0; m < 4; ++m)
#pragma unroll
                for (int bj = 0; bj < 2; ++bj) {
                    const size_t off = (size_t)(u.pm * BM + ai * HALF + wr * 64 + m * 16 + fr) * DM + colt + bj * HALF + wc * 32 + 8 * fq;
                    gq[m][bj] = *(const u32x4*)(SG + off);
                    if (STEP == 1) pq[m][bj] = *(const u32x4*)(M + off);
                }
#pragma unroll
            for (int m = 0; m < 4; ++m)
#pragma unroll
                for (int bj = 0; bj < 2; ++bj) {
                    const size_t off = (size_t)(u.pm * BM + ai * HALF + wr * 64 + m * 16 + fr) * DM + colt + bj * HALF + wc * 32 + 8 * fq;
                    float x[8];
#pragma unroll
                    for (int i = 0; i < 4; ++i) { x[i] = acc[ai][bj][m][0][i]; x[4 + i] = acc[ai][bj][m][1][i]; }
                    const u32x4 g = gq[m][bj];
                    const float gv[8] = {bflo(g.x), bfhi(g.x), bflo(g.y), bfhi(g.y), bflo(g.z), bfhi(g.z), bflo(g.w), bfhi(g.w)};
#pragma unroll
                    for (int i = 0; i < 8; ++i) x[i] *= gv[i];
                    if (STEP == 1) {
                        const u32x4 p = pq[m][bj];
                        const float pv[8] = {bflo(p.x), bfhi(p.x), bflo(p.y), bfhi(p.y), bflo(p.z), bfhi(p.z), bflo(p.w), bfhi(p.w)};
#pragma unroll
                        for (int i = 0; i < 8; ++i) x[i] += pv[i];
                    }
                    u32x4 w; w.x = cvt_pk_bf16(x[0], x[1]); w.y = cvt_pk_bf16(x[2], x[3]); w.z = cvt_pk_bf16(x[4], x[5]); w.w = cvt_pk_bf16(x[6], x[7]);
                    *(u32x4*)(M + off) = w;
                }
        }
    }
};
struct EpiOut {
    static constexpr bool PERM = true, AFTER_DRAIN = false;
    const bf16_t* Ub; const float* rmsx; const float* ginv; bf16_t* H;
    __device__ __forceinline__ void operator()(const f32x4 (&acc)[2][2][4][2], const Unit& u, int wr, int wc, int fr, int fq) const {
        f32x4 gi[2][2];
#pragma unroll
        for (int bj = 0; bj < 2; ++bj) { const int c0 = u.pn * BM + bj * HALF + wc * 32 + 8 * fq; gi[bj][0] = *(const f32x4*)(ginv + c0); gi[bj][1] = *(const f32x4*)(ginv + c0 + 4); }
#pragma unroll
        for (int ai = 0; ai < 2; ++ai) {
            u32x4 uq[4][2]; float rm[4];
#pragma unroll
            for (int m = 0; m < 4; ++m) {
                const int rp = u.pm * BM + ai * HALF + wr * 64 + m * 16 + fr;
                rm[m] = rmsx[rp];
#pragma unroll
                for (int bj = 0; bj < 2; ++bj) uq[m][bj] = *(const u32x4*)(Ub + (size_t)rp * DM + u.pn * BM + bj * HALF + wc * 32 + 8 * fq);
            }
#pragma unroll
            for (int m = 0; m < 4; ++m) {
                const int rp = u.pm * BM + ai * HALF + wr * 64 + m * 16 + fr;
#pragma unroll
                for (int bj = 0; bj < 2; ++bj) {
                    const size_t off = (size_t)rp * DM + u.pn * BM + bj * HALF + wc * 32 + 8 * fq;
                    const u32x4 uv = uq[m][bj];
                    const f32x4 x0 = (f32x4){bflo(uv.x), bfhi(uv.x), bflo(uv.y), bfhi(uv.y)} * gi[bj][0] * rm[m] + acc[ai][bj][m][0], x1 = (f32x4){bflo(uv.z), bfhi(uv.z), bflo(uv.w), bfhi(uv.w)} * gi[bj][1] * rm[m] + acc[ai][bj][m][1];
                    u32x4 w; w.x = cvt_pk_bf16(x0[0], x0[1]); w.y = cvt_pk_bf16(x0[2], x0[3]); w.z = cvt_pk_bf16(x1[0], x1[1]); w.w = cvt_pk_bf16(x1[2], x1[3]);
                    *(u32x4*)(H + off) = w;
                }
            }
        }
    }
};
}

__device__ __forceinline__ void p0_transpose_item(const float* W, int K, int N, bf16_t* WT, int dst_row0, LAS float* scr, int k0, int n0, int lane) {
#pragma unroll
    for (int i = 0; i < 8; ++i) { const int kk = 8 * i + (lane >> 3), c4 = (lane & 7) * 4;
        const f32x4 v = *(const f32x4*)(W + (size_t)(k0 + kk) * N + n0 + c4);
        scr[kk * 33 + c4] = v.x; scr[kk * 33 + c4 + 1] = v.y; scr[kk * 33 + c4 + 2] = v.z; scr[kk * 33 + c4 + 3] = v.w; }
    asm volatile("s_waitcnt lgkmcnt(0)" ::: "memory");
    const int c = lane & 7;
#pragma unroll
    for (int j = 0; j < 4; ++j) { const int n = (lane >> 3) + 8 * j; const LAS float* s = scr + (8 * c) * 33 + n;
        u32x4 o; o.x = pk2(s[0 * 33], s[1 * 33]); o.y = pk2(s[2 * 33], s[3 * 33]); o.z = pk2(s[4 * 33], s[5 * 33]); o.w = pk2(s[6 * 33], s[7 * 33]);
        *(u32x4*)(WT + (size_t)(dst_row0 + n) * K + k0 + 8 * c) = o; }
    asm volatile("s_waitcnt lgkmcnt(0)" ::: "memory");
}
__device__ __forceinline__ void u_row(const float* xrow, const float* g, bf16_t* orow, int lane, float* rinv) {
    u32x2* o8 = (u32x2*)orow + lane;
    if (!xrow) {
#pragma unroll
        for (int j = 0; j < 4; ++j) o8[64 * j] = (u32x2){0u, 0u};
        return;
    }
    const f32x4* xr = (const f32x4*)xrow + lane; const f32x4* gr = (const f32x4*)g + lane;
    f32x4 v[4]; float s = 0.f;
#pragma unroll
    for (int j = 0; j < 4; ++j) { v[j] = xr[64 * j]; s += (v[j].x * v[j].x + v[j].y * v[j].y) + (v[j].z * v[j].z + v[j].w * v[j].w); }
    const float rms = sqrtf(wave_sum(s) * (1.0f / DM) + 1e-6f), rstd = 1.0f / rms;
    if (rinv && lane == 0) *rinv = rms;
#pragma unroll
    for (int j = 0; j < 4; ++j) { const f32x4 gv = gr[64 * j];
        o8[64 * j] = (u32x2){pk2(v[j].x * rstd * gv.x, v[j].y * rstd * gv.y), pk2(v[j].z * rstd * gv.z, v[j].w * rstd * gv.w)}; }
}
__device__ __forceinline__ void sincos_d(float af, float& sn, float& cs) {
    const double a = (double)af;
    const double k = __builtin_rint(a * 0.15915494309189535);
    const double r = a - k * 6.283185307179586;
    const double r2 = r * r;
    double s = 0.0, c = 0.0;
    double ts = 1.0, tc = 1.0;
#pragma unroll
    for (int n = 0; n < 16; ++n) {
        s += ts; c += tc;
        ts = -ts * r2 / (double)((2 * n + 2) * (2 * n + 3));
        tc = -tc * r2 / (double)((2 * n + 1) * (2 * n + 2));
    }
    sn = (float)(s * r); cs = (float)c;
}

constexpr size_t WS_EV = 489 * MiB;
__device__ __forceinline__ void hgrn_prep_unit(ldsp lds, bf16_t* HQ, bf16_t* LF, float* EVG, int b, int c, int h, int par) {
    const int tid = threadIdx.x, lane = tid & 63, w = __builtin_amdgcn_readfirstlane(tid >> 6);
    const size_t go0 = ((size_t)b * LP + 64 * c + 8 * w) * DM + h * 128 + 2 * lane;
    unsigned qv[8], lv[8];
#pragma unroll
    for (int i = 0; i < 8; ++i) { qv[i] = *(const unsigned*)(HQ + go0 + (size_t)i * DM); lv[i] = *(const unsigned*)(LF + go0 + (size_t)i * DM); }
    float b0[8], b1[8], r0 = 0.f, r1 = 0.f;
#pragma unroll
    for (int i = 0; i < 8; ++i) { r0 += h2f((unsigned short)(lv[i] & 0xffffu)); r1 += h2f((unsigned short)(lv[i] >> 16)); b0[i] = r0; b1[i] = r1; }
    ldsp wt = lds + par * 4096;
    *(LAS f32x2v*)(wt + (w * 128 + 2 * lane) * 4) = (f32x2v){r0, r1};
    LBAR();
    float pre0 = 0.f, pre1 = 0.f, ref0 = 0.f, ref1 = 0.f, bl0 = 0.f, bl1 = 0.f;
#pragma unroll
    for (int ww = 0; ww < 8; ++ww) { const f32x2v t = *(const LAS f32x2v*)(wt + (ww * 128 + 2 * lane) * 4);
        if (ww < w) { pre0 += t.x; pre1 += t.y; } if (ww < 4) { ref0 += t.x; ref1 += t.y; } bl0 += t.x; bl1 += t.y; }
    if (w == 0) {
        float* ev = EVG + ((size_t)((b * 8 + h) * 66 + c)) * 384 + 2 * lane;
        *(f32x2v*)(ev) = (f32x2v){fexp2(ref0 * LOG2E), fexp2(ref1 * LOG2E)};
        *(f32x2v*)(ev + 128) = (f32x2v){fexp2(bl0 * LOG2E), fexp2(bl1 * LOG2E)};
        *(f32x2v*)(ev + 256) = (f32x2v){fexp2(fmaxf(bl0 - ref0, -100.f) * LOG2E), fexp2(fmaxf(bl1 - ref1, -100.f) * LOG2E)};
    }
#pragma unroll
    for (int i = 0; i < 8; ++i) {
        const float d0 = fminf(fmaxf(pre0 + b0[i] - ref0, -80.f), 80.f), d1 = fminf(fmaxf(pre1 + b1[i] - ref1, -80.f), 80.f);
        const float e10 = fexp2(d0 * LOG2E), e11 = fexp2(d1 * LOG2E);
        const float e20 = __builtin_amdgcn_rcpf(e10), e21 = __builtin_amdgcn_rcpf(e11);
        const float k0 = 1.0f - fexp2(h2f((unsigned short)(lv[i] & 0xffffu)) * LOG2E), k1 = 1.0f - fexp2(h2f((unsigned short)(lv[i] >> 16)) * LOG2E);
        *(unsigned*)(HQ + go0 + (size_t)i * DM) = pk2(bflo(qv[i]) * e10, bfhi(qv[i]) * e11);
        *(unsigned*)(LF + go0 + (size_t)i * DM) = pk2(k0 * e20, k1 * e21);
    }
}

constexpr int HG_STR = 272;
constexpr int HG_QE = 0;
constexpr int HG_KE = HG_QE + 64 * HG_STR;
constexpr int HG_V = HG_KE + 64 * HG_STR;
constexpr int HG_A1 = HG_V + 64 * HG_STR, HG_TSTR = 144;
constexpr int HG_EV = HG_A1 + 64 * HG_TSTR;
constexpr int HG_SS = HG_EV + 3 * 128 * 4;
constexpr int HG_END = HG_SS + 8 * 64 * 4;
static_assert(HG_END <= 131072, "HGRN LDS");
typedef short v4i16_t __attribute__((ext_vector_type(4)));
__device__ __forceinline__ s16x4 vtr(ldsp p) { return __builtin_bit_cast(s16x4, __builtin_amdgcn_ds_read_tr16_b64_v4i16((LAS v4i16_t*)p)); }

__device__ __forceinline__ void hgrn_seq(ldsp lds, const bf16_t* HQ, const bf16_t* LF, const bf16_t* HI, const float* EVG, bf16_t* OA, float* SSQ, const float* gA, int b, int h) {
    const int tid = threadIdx.x, lane = tid & 63, w = __builtin_amdgcn_readfirstlane(tid >> 6), fr = lane & 15, fq = lane >> 4;
    const size_t rowb = (size_t)(b * 8 + h) * LP;
    f32x4 S[8];
#pragma unroll
    for (int i = 0; i < 8; ++i) S[i] = (f32x4){0.f, 0.f, 0.f, 0.f};
    const int srow = tid >> 3, sch = (tid & 7) * 2;
    const size_t gcol = (size_t)sch * 8;
    u32x4 rq0, rq1, rk0, rk1, rv0, rv1; f32x4 rev = (f32x4){0.f, 0.f, 0.f, 0.f};
#define HG_LOAD(c) do { const size_t go = (rowb + 64 * (c) + srow) * 128 + gcol; \
        rq0 = *(const u32x4*)(HQ + go); rq1 = *(const u32x4*)(HQ + go + 8); rk0 = *(const u32x4*)(LF + go); rk1 = *(const u32x4*)(LF + go + 8); \
        rv0 = *(const u32x4*)(HI + go); rv1 = *(const u32x4*)(HI + go + 8); \
        if (tid < 96) rev = *(const f32x4*)(EVG + ((size_t)((b * 8 + h) * 66 + (c))) * 384 + tid * 4); } while (0)
    HG_LOAD(1);
    const float gv = gA[16 * w + fr];
    const int trq = fr >> 2, trp = fr & 3;
    for (int c = 1; c <= 65; ++c) {
        LBAR();
        *(LAS u32x4*)(lds + HG_QE + srow * HG_STR + sch * 16) = rq0; *(LAS u32x4*)(lds + HG_QE + srow * HG_STR + sch * 16 + 16) = rq1;
        *(LAS u32x4*)(lds + HG_KE + srow * HG_STR + sch * 16) = rk0; *(LAS u32x4*)(lds + HG_KE + srow * HG_STR + sch * 16 + 16) = rk1;
        *(LAS u32x4*)(lds + HG_V + srow * HG_STR + sch * 16) = rv0; *(LAS u32x4*)(lds + HG_V + srow * HG_STR + sch * 16 + 16) = rv1;
        if (tid < 96) *(LAS f32x4*)(lds + HG_EV + tid * 16) = rev;
        if (c < 65) HG_LOAD(c + 1);
        LBAR();
        {
            const int ti = w >> 1;
#pragma unroll
            for (int e = 0; e < 2; ++e) {
                const int si = 2 * (w & 1) + e;
                f32x4 a = (f32x4){0.f, 0.f, 0.f, 0.f};
                if (si <= ti) {
#pragma unroll
                    for (int ks = 0; ks < 4; ++ks) {
                        const bf16x8 qa = *(const LAS bf16x8*)(lds + HG_QE + (16 * ti + fr) * HG_STR + (32 * ks + 8 * fq) * 2);
                        const bf16x8 kb = *(const LAS bf16x8*)(lds + HG_KE + (16 * si + fr) * HG_STR + (32 * ks + 8 * fq) * 2);
                        a = __builtin_amdgcn_mfma_f32_16x16x32_bf16(qa, kb, a, 0, 0, 0);
                    }
                }
                const int s = 16 * si + fr;
#pragma unroll
                for (int i = 0; i < 4; ++i) { const int t = 16 * ti + 4 * fq + i; const float val = (s <= t) ? a[i] : 0.f;
                    *(LAS unsigned short*)(lds + HG_A1 + t * HG_TSTR + 2 * s) = (unsigned short)(pk2(val, 0.f) & 0xffffu); }
            }
        }
        bf16x8 vf[2];
#pragma unroll
        for (int ks = 0; ks < 2; ++ks) {
            const s16x4 lo = vtr(lds + HG_V + (32 * ks + 8 * fq + trq) * HG_STR + (16 * w + 4 * trp) * 2);
            const s16x4 hi = vtr(lds + HG_V + (32 * ks + 8 * fq + 4 + trq) * HG_STR + (16 * w + 4 * trp) * 2);
            vf[ks] = __builtin_shufflevector(lo, hi, 0, 1, 2, 3, 4, 5, 6, 7);
        }
        bf16x8 sp[4];
#pragma unroll
        for (int a = 0; a < 4; ++a) {
            const f32x4 e0 = *(const LAS f32x4*)(lds + HG_EV + (32 * a + 4 * fq) * 4), e1 = *(const LAS f32x4*)(lds + HG_EV + (32 * a + 16 + 4 * fq) * 4);
            const f32x4 x0 = S[2 * a] * e0, x1 = S[2 * a + 1] * e1;
            const u32x4 pk = (u32x4){pk2(x0[0], x0[1]), pk2(x0[2], x0[3]), pk2(x1[0], x1[1]), pk2(x1[2], x1[3])};
            sp[a] = __builtin_bit_cast(bf16x8, pk);
        }
#pragma unroll
        for (int dt = 0; dt < 8; ++dt) {
            f32x4 acc = (f32x4){0.f, 0.f, 0.f, 0.f};
#pragma unroll
            for (int ks = 0; ks < 2; ++ks) {
                const s16x4 lo = vtr(lds + HG_KE + (32 * ks + 8 * fq + trq) * HG_STR + (16 * dt + 4 * trp) * 2);
                const s16x4 hi = vtr(lds + HG_KE + (32 * ks + 8 * fq + 4 + trq) * HG_STR + (16 * dt + 4 * trp) * 2);
                const bf16x8 kf = __builtin_shufflevector(lo, hi, 0, 1, 2, 3, 4, 5, 6, 7);
                acc = __builtin_amdgcn_mfma_f32_16x16x32_bf16(kf, vf[ks], acc, 0, 0, 0);
            }
            const f32x4 el = *(const LAS f32x4*)(lds + HG_EV + (128 + 16 * dt + 4 * fq) * 4), elm = *(const LAS f32x4*)(lds + HG_EV + (256 + 16 * dt + 4 * fq) * 4);
            S[dt] = S[dt] * el + acc * elm;
        }
        LBAR();
        f32x4 o[4];
#pragma unroll
        for (int tt = 0; tt < 4; ++tt) {
            f32x4 acc = (f32x4){0.f, 0.f, 0.f, 0.f};
#pragma unroll
            for (int ks = 0; ks < 2; ++ks) {
                const bf16x8 af = *(const LAS bf16x8*)(lds + HG_A1 + (16 * tt + fr) * HG_TSTR + (32 * ks + 8 * fq) * 2);
                acc = __builtin_amdgcn_mfma_f32_16x16x32_bf16(af, vf[ks], acc, 0, 0, 0);
            }
#pragma unroll
            for (int a = 0; a < 4; ++a) {
                const s16x4 lo = *(const LAS s16x4*)(lds + HG_QE + (16 * tt + fr) * HG_STR + (32 * a + 4 * fq) * 2);
                const s16x4 hi = *(const LAS s16x4*)(lds + HG_QE + (16 * tt + fr) * HG_STR + (32 * a + 16 + 4 * fq) * 2);
                const bf16x8 qa = __builtin_shufflevector(lo, hi, 0, 1, 2, 3, 4, 5, 6, 7);
                acc = __builtin_amdgcn_mfma_f32_16x16x32_bf16(qa, sp[a], acc, 0, 0, 0);
            }
            o[tt] = acc;
        }
        if (c >= 2) {
#pragma unroll
            for (int tt = 0; tt < 4; ++tt) {
                f32x4 q = o[tt] * o[tt];
#pragma unroll
                for (int sh = 1; sh < 16; sh <<= 1) { q[0] += __shfl_xor(q[0], sh); q[1] += __shfl_xor(q[1], sh); q[2] += __shfl_xor(q[2], sh); q[3] += __shfl_xor(q[3], sh); }
                const int s0 = 64 * c + 16 * tt + 4 * fq - 128;
                if (fr == 0) *(f32x4*)(SSQ + ((size_t)((b * 8 + h) * 8 + w)) * SEQ + s0) = q;
#pragma unroll
                for (int i = 0; i < 4; ++i)
                    OA[((size_t)b * SEQ + s0 + i) * DM + h * 128 + 16 * w + fr] = (bf16_t)(pk2(o[tt][i] * gv, 0.f) & 0xffffu);
            }
        }
    }
#undef HG_LOAD
    __syncthreads();
}

constexpr int AT_SLOT = 65536, AT_VOFF = 32768;
constexpr int AT_X = 0;
__device__ __forceinline__ int crow(int r, int hi) { return (r & 3) + 8 * (r >> 2) + 4 * hi; }
typedef __bf16 bf16x2_t __attribute__((ext_vector_type(2)));
__device__ __forceinline__ unsigned cvtpk_s(float lo, float hi) { f32x2v v = {lo, hi}; bf16x2_t bb = __builtin_convertvector(v, bf16x2_t); return __builtin_bit_cast(unsigned, bb); }
__device__ __forceinline__ float max3f(float a, float b, float c) { return fmaxf(fmaxf(a, b), c); }
constexpr float AT_THR = 8.0f;

__device__ __forceinline__ void attn_unit(ldsp lds, const bf16_t* AQ, const bf16_t* AK, const bf16_t* AV, bf16_t* OB, const float* gB, float lam, int b, int h, int qblk) {
    const int tid = threadIdx.x, lane = tid & 63, w = __builtin_amdgcn_readfirstlane(tid >> 6), comp = w >> 2, qsub = w & 3, r = lane & 31, hi = lane >> 5;
    const int L0 = qblk * 128;
    const size_t rowb = (size_t)(b * 8 + h) * LP;
    const int qL = L0 + 32 * qsub + r;
    int gk[4], gv[4];
    {
        const int l4 = lane >> 4, p16 = lane & 15;
#pragma unroll
        for (int i = 0; i < 4; ++i) { const int row = 16 * w + 4 * i + l4;
            gk[i] = row * 128 + ((p16 ^ (row & 15)) << 3);
            gv[i] = row * 128 + ((p16 ^ ((row & 3) << 2)) << 3); }
    }
#define AT_DMA(j) do { const bf16_t* kb_ = AK + (rowb + 128 * (j)) * 128; const bf16_t* vb_ = AV + (rowb + 128 * (j)) * 128; const int so_ = ((j) & 1) * AT_SLOT + 4 * w * 1024; \
        _Pragma("unroll") for (int i_ = 0; i_ < 4; ++i_) { \
            __builtin_amdgcn_global_load_lds((const unsigned*)(kb_ + gk[i_]), (LAS unsigned*)(lds + so_ + i_ * 1024), 16, 0, 0); \
            __builtin_amdgcn_global_load_lds((const unsigned*)(vb_ + gv[i_]), (LAS unsigned*)(lds + so_ + AT_VOFF + i_ * 1024), 16, 0, 0); } } while (0)
    LBAR();
    if (w >= 6) AT_DMA(0);
    AT_DMA(1);
    bf16x8 qf[4];
    {
        const bf16_t* qp = AQ + (rowb + qL) * 128 + comp * 64 + 8 * hi;
#pragma unroll
        for (int ks = 0; ks < 4; ++ks) qf[ks] = *(const bf16x8*)(qp + 16 * ks);
    }
    f32x16 o[4];
#pragma unroll
    for (int t4 = 0; t4 < 4; ++t4)
#pragma unroll
        for (int i = 0; i < 16; ++i) o[t4][i] = 0.f;
    float mhat = 0.f, lrun = 0.f;
    int kaddr[4], vaddr[4];
    {
        const int q_ = (lane & 15) >> 2, p_ = lane & 3, g1 = (lane >> 4) & 1;
#pragma unroll
        for (int ks = 0; ks < 4; ++ks) kaddr[ks] = r * 256 + (((comp * 8 + 2 * ks + hi) ^ (r & 15)) << 4);
#pragma unroll
        for (int t4 = 0; t4 < 4; ++t4) vaddr[t4] = AT_VOFF + (4 * hi + q_) * 256 + ((((t4 ^ q_) << 2) + g1 * 2 + (p_ >> 1)) << 4) + (p_ & 1) * 8;
    }
    asm volatile("s_waitcnt vmcnt(0)" ::: "memory");
    LBAR();
    {
        f32x16 s3;
#pragma unroll
        for (int i = 0; i < 16; ++i) s3[i] = 0.f;
#pragma unroll
        for (int ks = 0; ks < 4; ++ks) { const bf16x8 kf = *(const LAS bf16x8*)(lds + kaddr[ks] + 3 * 8192); s3 = __builtin_amdgcn_mfma_f32_32x32x16_bf16(kf, qf[ks], s3, 0, 0, 0); }
#pragma unroll
        for (int i = 0; i < 16; ++i) if (96 + crow(i, hi) < PADN) s3[i] = -1e30f;
        float rm = s3[0];
#pragma unroll
        for (int i = 1; i < 16; ++i) rm = fmaxf(rm, s3[i]);
        rm = fmaxf(rm, __shfl_xor(rm, 32));
        mhat = rm;
        float ls = 0.f;
#pragma unroll
        for (int i = 0; i < 16; ++i) { s3[i] = fexp2(s3[i] - rm); ls += s3[i]; }
        lrun = ls;
        u32x4 p0 = (u32x4){cvtpk_s(s3[0], s3[1]), cvtpk_s(s3[2], s3[3]), cvtpk_s(s3[4], s3[5]), cvtpk_s(s3[6], s3[7])};
        u32x4 p1 = (u32x4){cvtpk_s(s3[8], s3[9]), cvtpk_s(s3[10], s3[11]), cvtpk_s(s3[12], s3[13]), cvtpk_s(s3[14], s3[15])};
        const bf16x8 pa0 = __builtin_bit_cast(bf16x8, p0), pa1 = __builtin_bit_cast(bf16x8, p1);
#pragma unroll
        for (int t4 = 0; t4 < 4; ++t4) {
            const s16x4 lo0 = vtr(lds + vaddr[t4] + 96 * 256), hv0 = vtr(lds + vaddr[t4] + 104 * 256), lo1 = vtr(lds + vaddr[t4] + 112 * 256), hv1 = vtr(lds + vaddr[t4] + 120 * 256);
            const bf16x8 vf0 = __builtin_shufflevector(lo0, hv0, 0, 1, 2, 3, 4, 5, 6, 7), vf1 = __builtin_shufflevector(lo1, hv1, 0, 1, 2, 3, 4, 5, 6, 7);
            o[t4] = __builtin_amdgcn_mfma_f32_32x32x16_bf16(vf0, pa0, o[t4], 0, 0, 0);
            o[t4] = __builtin_amdgcn_mfma_f32_32x32x16_bf16(vf1, pa1, o[t4], 0, 0, 0);
        }
    }
    LBAR();
    auto tile = [&](const int j, auto DIAG) __attribute__((always_inline)) {
        constexpr bool diag = decltype(DIAG)::value;
        if (!diag) AT_DMA(j + 1);
        const ldsp sl = lds + (j & 1) * AT_SLOT;
        {
            f32x16 s[4];
            {
                f32x16 negm;
#pragma unroll
                for (int i = 0; i < 16; ++i) negm[i] = -mhat;
#pragma unroll
                for (int ks = 0; ks < 4; ++ks) {
                    bf16x8 kf[4];
#pragma unroll
                    for (int sb = 0; sb < 4; ++sb) kf[sb] = *(const LAS bf16x8*)(sl + kaddr[ks] + sb * 8192);
#pragma unroll
                    for (int sb = 0; sb < 4; ++sb) s[sb] = __builtin_amdgcn_mfma_f32_32x32x16_bf16(kf[sb], qf[ks], ks == 0 ? negm : s[sb], 0, 0, 0);
                }
            }
            if constexpr (diag) {
#pragma unroll
                for (int sb = 0; sb < 4; ++sb)
#pragma unroll
                    for (int i = 0; i < 16; ++i) { const int key = 128 * j + 32 * sb + crow(i, hi); if (key > qL) s[sb][i] = -1e30f; }
            }
            float ma = max3f(s[0][0], s[0][1], s[0][2]), mb = max3f(s[0][3], s[1][0], s[1][1]);
#pragma unroll
            for (int sb = 0; sb < 4; ++sb)
#pragma unroll
                for (int i = 0; i < 16; i += 4) { ma = max3f(ma, s[sb][i], s[sb][i + 1]); mb = max3f(mb, s[sb][i + 2], s[sb][i + 3]); }
            float rm = fmaxf(ma, mb);
            rm = fmaxf(rm, __shfl_xor(rm, 32));
            if (__any(rm > AT_THR)) {
                const float dl = fmaxf(rm, 0.f);
                mhat += dl;
#pragma unroll
                for (int sb = 0; sb < 4; ++sb)
#pragma unroll
                    for (int i = 0; i < 16; ++i) s[sb][i] -= dl;
                const float f = fexp2(-dl);
                lrun *= f;
#pragma unroll
                for (int t4 = 0; t4 < 4; ++t4)
#pragma unroll
                    for (int i = 0; i < 16; ++i) o[t4][i] *= f;
            }
            float ls0 = 0.f, ls1 = 0.f;
#pragma unroll
            for (int sb = 0; sb < 4; ++sb) {
#pragma unroll
                for (int i = 0; i < 16; i += 2) { s[sb][i] = fexp2(s[sb][i]); s[sb][i + 1] = fexp2(s[sb][i + 1]); ls0 += s[sb][i]; ls1 += s[sb][i + 1]; }
                u32x4 p0 = (u32x4){cvtpk_s(s[sb][0], s[sb][1]), cvtpk_s(s[sb][2], s[sb][3]), cvtpk_s(s[sb][4], s[sb][5]), cvtpk_s(s[sb][6], s[sb][7])};
                u32x4 p1 = (u32x4){cvtpk_s(s[sb][8], s[sb][9]), cvtpk_s(s[sb][10], s[sb][11]), cvtpk_s(s[sb][12], s[sb][13]), cvtpk_s(s[sb][14], s[sb][15])};
                const bf16x8 pa0 = __builtin_bit_cast(bf16x8, p0), pa1 = __builtin_bit_cast(bf16x8, p1);
                bf16x8 vf0[4], vf1[4];
#pragma unroll
                for (int t4 = 0; t4 < 4; ++t4) {
                    const s16x4 lo0 = vtr(sl + vaddr[t4] + (32 * sb) * 256);
                    const s16x4 hv0 = vtr(sl + vaddr[t4] + (32 * sb + 8) * 256);
                    const s16x4 lo1 = vtr(sl + vaddr[t4] + (32 * sb + 16) * 256);
                    const s16x4 hv1 = vtr(sl + vaddr[t4] + (32 * sb + 24) * 256);
                    vf0[t4] = __builtin_shufflevector(lo0, hv0, 0, 1, 2, 3, 4, 5, 6, 7);
                    vf1[t4] = __builtin_shufflevector(lo1, hv1, 0, 1, 2, 3, 4, 5, 6, 7);
                }
#pragma unroll
                for (int t4 = 0; t4 < 4; ++t4) o[t4] = __builtin_amdgcn_mfma_f32_32x32x16_bf16(vf0[t4], pa0, o[t4], 0, 0, 0);
#pragma unroll
                for (int t4 = 0; t4 < 4; ++t4) o[t4] = __builtin_amdgcn_mfma_f32_32x32x16_bf16(vf1[t4], pa1, o[t4], 0, 0, 0);
            }
            lrun += ls0 + ls1;
        }
        asm volatile("s_waitcnt vmcnt(0)" ::: "memory");
        LBAR();
    };
    for (int j = 1; j < qblk; ++j) tile(j, std::false_type{});
    tile(qblk, std::true_type{});
#undef AT_DMA
    lrun += __shfl_xor(lrun, 32);
    const float inv = 1.0f / lrun;
    if (comp == 1) {
#pragma unroll
        for (int t4 = 0; t4 < 4; ++t4)
#pragma unroll
            for (int i = 0; i < 16; ++i) *(LAS float*)(lds + AT_X + ((qsub * 64 + t4 * 16 + i) * 64 + lane) * 4) = o[t4][i] * inv;
    }
    LBAR();
    if (comp == 0) {
        float ss = 0.f;
#pragma unroll
        for (int t4 = 0; t4 < 4; ++t4)
#pragma unroll
            for (int i = 0; i < 16; ++i) { const float x2 = *(const LAS float*)(lds + AT_X + ((qsub * 64 + t4 * 16 + i) * 64 + lane) * 4);
                const float v = o[t4][i] * inv - lam * x2; o[t4][i] = v; ss += v * v; }
        ss += __shfl_xor(ss, 32);
        const float rstd = 0.8f / sqrtf(ss * (1.0f / 128.0f) + 1e-6f);
        bf16_t* op = OB + ((size_t)b * SEQ + (qL - 128)) * DM + h * 128;
#pragma unroll
        for (int t4 = 0; t4 < 4; ++t4)
#pragma unroll
            for (int g4 = 0; g4 < 4; ++g4) {
                const int dv = 32 * t4 + 8 * g4 + 4 * hi;
                const f32x4 gg = *(const f32x4*)(gB + dv);
                const u32x2 pk = (u32x2){pk2(o[t4][4 * g4] * rstd * gg[0], o[t4][4 * g4 + 1] * rstd * gg[1]), pk2(o[t4][4 * g4 + 2] * rstd * gg[2], o[t4][4 * g4 + 3] * rstd * gg[3])};
                *(u32x2*)(op + dv) = pk;
            }
    }
}

__device__ __forceinline__ f32x4 meta_dot(const bf16_t* ua, const bf16_t* wb) {
    f32x4 c0 = (f32x4){0.f, 0.f, 0.f, 0.f}, c1 = c0;
#pragma unroll 4
    for (int ks = 0; ks < 32; ks += 2) {
        const bf16x8 a0 = *(const bf16x8*)(ua + 32 * ks), b0 = *(const bf16x8*)(wb + 32 * ks);
        const bf16x8 a1 = *(const bf16x8*)(ua + 32 * ks + 32), b1 = *(const bf16x8*)(wb + 32 * ks + 32);
        c0 = __builtin_amdgcn_mfma_f32_16x16x32_bf16(a0, b0, c0, 0, 0, 0);
        c1 = __builtin_amdgcn_mfma_f32_16x16x32_bf16(a1, b1, c1, 0, 0, 0);
    }
    return c0 + c1;
}
__device__ __forceinline__ void meta_task(const bf16_t* U, const bf16_t* WIN, bf16_t* P, const float* lb, const float* rope, float* EVG, int task, int lane) {
    const int fr = lane & 15, fq = lane >> 4;
    const bf16_t* ua = U + (size_t)(MREAL + fr) * DM + 8 * fq;
    if (task < 64) {
        const int t = task >> 3, uu = task & 7, ch = 16 * uu + fr;
        const f32x4 cq = meta_dot(ua, WIN + (size_t)(256 * t + 16 * uu + fr) * DM + 8 * fq);
        const f32x4 cf = meta_dot(ua, WIN + (size_t)(256 * t + 128 + 16 * uu + fr) * DM + 8 * fq);
        const float lbv = lb[t * 128 + ch];
        float f[4], bc[4], run = 0.f;
#pragma unroll
        for (int i = 0; i < 4; ++i) { f[i] = lbv + (1.0f - lbv) * sigmoidf_(cf[i]); run += __logf(f[i]); bc[i] = run; }
        const float t16 = __shfl_up(run, 16), t32 = __shfl_up(run, 32), t48 = __shfl_up(run, 48);
        const float pre = (fq >= 1 ? t16 : 0.f) + (fq >= 2 ? t32 : 0.f) + (fq >= 3 ? t48 : 0.f);
        const float bl = __shfl(pre + run, 48 + fr);
        unsigned short oq[4], ok[4];
#pragma unroll
        for (int i = 0; i < 4; ++i) {
            const float d = fminf(fmaxf(pre + bc[i], -80.f), 80.f);
            const float e1 = fexp2(d * LOG2E), e2 = __builtin_amdgcn_rcpf(e1);
            oq[i] = (unsigned short)(pk2(cq[i] * e1, 0.f) & 0xffffu); ok[i] = (unsigned short)(pk2((1.0f - f[i]) * e2, 0.f) & 0xffffu);
        }
        const float elv = fexp2(bl * LOG2E);
        for (int b = 0; b < NB; ++b) {
#pragma unroll
            for (int i = 0; i < 4; ++i) { const size_t off = ((size_t)(b * 8 + t) * LP + PADN + 4 * fq + i) * 128 + ch; P[off] = oq[i]; P[PSTRIDE + off] = ok[i]; }
            if (fq == 0) { float* ev = EVG + ((size_t)((b * 8 + t) * 66 + 1)) * 384 + ch; ev[0] = 1.0f; ev[128] = elv; ev[256] = fexp2(fmaxf(bl, -100.f) * LOG2E); }
        }
        return;
    }
    const int n0 = 2048 + 16 * (task - 64), seg = 2 + ((n0 - 2048) >> 10), col = ((n0 - 2048) & 1023) + fr;
    f32x4 c = meta_dot(ua, WIN + (size_t)(n0 + fr) * DM + 8 * fq);
    if ((seg == 3 || seg == 4) && ((n0 & 63) == 0)) {
#pragma unroll
        for (int i = 0; i < 4; ++i) {
            const float p = __shfl_xor(c[i], 8);
            const float* rt = rope + (size_t)(4 * fq + i) * 16;
            const float cs = rt[fr & 7], sn = rt[8 + (fr & 7)];
            c[i] = (fr < 8) ? c[i] * cs - p * sn : c[i] * cs + p * sn;
        }
    }
    if (seg == 3) c = c * QSCALE;
    bf16_t* base = P + (size_t)seg * PSTRIDE + (col & 127);
#pragma unroll
    for (int i = 0; i < 4; ++i) { const unsigned short ob = (unsigned short)(pk2(c[i], 0.f) & 0xffffu);
        for (int b = 0; b < NB; ++b) base[((size_t)(b * 8 + (col >> 7)) * LP + PADN + 4 * fq + i) * 128] = ob; }
}

constexpr size_t WS_XBAR = 896 * 1024;
#define XB_TMO      128
#define XB_XCNT(j)  (256  + 64 * (j))
#define XB_XSUB(j)  (1280 + 64 * (j))
#define XB_XGEN(j)  (2304 + 64 * (j))
#define XB_TOP      3328
#define XB_TOPGEN   3392
#define XCD_BAR_WORDS 3456
#define XB_SPIN_CAP (1u << 18)

__device__ __forceinline__ unsigned xb_ld(unsigned* p)              { return __hip_atomic_load(p, __ATOMIC_RELAXED, __HIP_MEMORY_SCOPE_AGENT); }
__device__ __forceinline__ unsigned xb_add(unsigned* p, unsigned v) { return __hip_atomic_fetch_add(p, v, __ATOMIC_RELAXED, __HIP_MEMORY_SCOPE_AGENT); }
__device__ __forceinline__ unsigned xb_xcc_id() { return (unsigned)__builtin_amdgcn_s_getreg((3 << 11) | 20) & 0xFu; }
#define XB_SPIN(cond, bar) do { unsigned _sp = 0; while (cond) { __builtin_amdgcn_s_sleep(1); \
    if ((++_sp & 255u) == 0u) { if (xb_ld(&(bar)[XB_TMO])) break; if (_sp > XB_SPIN_CAP) { atomicAdd(&(bar)[XB_TMO], 1u); break; } } } } while (0)

struct XcdBarrier {
    unsigned* bar; unsigned x;
    volatile LAS unsigned* st;
};

__device__ __forceinline__ XcdBarrier xcd_barrier_post(unsigned* bar, volatile LAS unsigned* st) {
    XcdBarrier b; b.bar = bar; b.x = xb_xcc_id(); b.st = st;
    if (threadIdx.x == 0) (void)xb_add(&bar[XB_XCNT(b.x)], 1u);
    return b;
}
__device__ __forceinline__ void xcd_barrier_complete(unsigned* bar, unsigned x, unsigned& nloc, unsigned& nx) {
    const unsigned G = gridDim.x * gridDim.y * gridDim.z;
    unsigned sum, cnt, mine, sp = 0u;
    for (;;) {
        sum = 0u; cnt = 0u; mine = 0u;
#pragma unroll
        for (unsigned j = 0; j < 16; ++j) { const unsigned c = xb_ld(&bar[XB_XCNT(j)]); sum += c; cnt += (c > 0u) ? 1u : 0u; mine = (j == x) ? c : mine; }
        if (sum == G) break;
        __builtin_amdgcn_s_sleep(1);
        if ((++sp & 255u) == 0u) { if (xb_ld(&bar[XB_TMO])) break; if (sp > XB_SPIN_CAP) { atomicAdd(&bar[XB_TMO], 1u); break; } }
    }
    nloc = mine > 0u ? mine : 1u; nx = cnt > 0u ? cnt : 1u;
}

__device__ __forceinline__ void xcd_barrier(const XcdBarrier& b) {
    asm volatile("s_waitcnt vmcnt(0)" ::: "memory");
    __syncthreads();
    if (threadIdx.x == 0) {
        unsigned* bar = b.bar;
        __builtin_amdgcn_s_waitcnt(0);
        unsigned nloc = b.st[0], nx = b.st[1];
        if (nloc == 0u) { xcd_barrier_complete(bar, b.x, nloc, nx); b.st[0] = nloc; b.st[1] = nx; }
        const unsigned old = xb_add(&bar[XB_XSUB(b.x)], 1u);
        const unsigned gen = old / nloc;
        if (old + 1u == (gen + 1u) * nloc) {
            __builtin_amdgcn_fence(__ATOMIC_RELEASE, "agent");
            asm volatile("s_waitcnt vmcnt(0)" ::: "memory");
            const unsigned og = xb_add(&bar[XB_TOP], 1u);
            const unsigned tg = og / nx;
            if (og + 1u == (tg + 1u) * nx) xb_add(&bar[XB_TOPGEN], 1u);
            else XB_SPIN(xb_ld(&bar[XB_TOPGEN]) == tg, bar);
            __builtin_amdgcn_fence(__ATOMIC_ACQUIRE, "agent");
            xb_add(&bar[XB_XGEN(b.x)], 1u);
            asm volatile("s_waitcnt vmcnt(0)" ::: "memory");
        } else {
            XB_SPIN(xb_ld(&bar[XB_XGEN(b.x)]) == gen, bar);
            __builtin_amdgcn_fence(__ATOMIC_ACQUIRE, "agent");
            asm volatile("s_waitcnt vmcnt(0)" ::: "memory");
        }
    }
    __syncthreads();
}

#ifndef REPMASK
#define REPMASK 0
#endif
#define NREP(k) ((((REPMASK) >> (k)) & 1) + 1)
struct Args { const float* in[12]; float* out; unsigned char* ws; int ph_lo, ph_hi, flags, pad; };
constexpr int NPH = 7;

__global__ void __launch_bounds__(512, 2) mega_fwd(Args args) {
    extern __shared__ __attribute__((aligned(16))) unsigned char lds_raw[];
    ldsp lds = (ldsp)lds_raw;
    const int tid = threadIdx.x, lane = tid & 63, wave = __builtin_amdgcn_readfirstlane(tid >> 6);
    const int G = gridDim.x, bx = blockIdx.x;
    unsigned char* ws = args.ws;
    const float* x = args.in[0]; const float* meta = args.in[1]; const float* norm_g = args.in[2]; const float* w_in = args.in[3];
    const float* lb_logits = args.in[4]; const float* hg_g = args.in[5]; const float* da_lambda = args.in[6]; const float* da_g = args.in[7];
    const float* w_a = args.in[8]; const float* w_b = args.in[9]; const float* w_o = args.in[10]; const float* final_g = args.in[11];
    unsigned* ctl = (unsigned*)(ws + WS_CTL);
    float* lamp = (float*)(ws + WS_CTL + 1024);
    float* lbt = (float*)(ws + WS_LB);
    float* rope = (float*)(ws + WS_ROPE);
    float* rmsx = (float*)(ws + 512 * 1024);
    float* ginv = (float*)(ws + 768 * 1024);
    bf16_t* WIN = (bf16_t*)(ws + WS_WIN); bf16_t* WA = (bf16_t*)(ws + WS_WA); bf16_t* WB = (bf16_t*)(ws + WS_WB); bf16_t* WO = (bf16_t*)(ws + WS_WO);
    bf16_t* U = (bf16_t*)(ws + WS_U);
    float* EVG = (float*)(ws + WS_EV);
    float* SSQ = (float*)(ws + WS_SSQ);
    bf16_t* P = (bf16_t*)(ws + WS_P);
    bf16_t* OAB = (bf16_t*)args.out;
    const int lo = args.ph_lo, hi = args.ph_hi;
    cg::grid_group grid = cg::this_grid();
    volatile LAS unsigned* bst = (volatile LAS unsigned*)(lds + 131072 + 16);
    if (tid == 0) { bst[0] = 0u; bst[1] = 0u; }
    __syncthreads();
    const XcdBarrier xbar = xcd_barrier_post((unsigned*)(ws + WS_XBAR), bst);
    if (args.flags == 0x7fffffff) grid.sync();
#define IN(k) (lo <= (k) && (k) < hi)
#define SEAM(k) do { if (IN(k) && IN((k) + 1)) xcd_barrier(xbar); } while (0)

    if (IN(0)) for (int rep_ = 0; rep_ < NREP(0); ++rep_) {
        if (rep_) grid.sync();
        const int gw = bx * 8 + wave, NGW = G * 8;
        const int gt = bx * 512 + tid, NGT = G * 512;
        if (bx == 0 && tid < 8) ctl[16 * tid] = 0u;
        if (bx == 0 && tid == 0) {
            float s1 = 0.f, s2 = 0.f;
            for (int i = 0; i < 64; ++i) { s1 += da_lambda[i] * da_lambda[64 + i]; s2 += da_lambda[128 + i] * da_lambda[192 + i]; }
            *lamp = expf(s1) - expf(s2) + 0.2f;
        }
        for (int i = gt; i < 1024; i += NGT) { const float l0 = lb_logits[i], l1 = lb_logits[1024 + i]; lbt[i] = 1.0f / (1.0f + expf(l1 - l0)); ginv[i] = 1.0f / norm_g[i]; }
        for (int i = gt; i < 4112 * 8; i += NGT) { const int pos = i >> 3, j = i & 7;
            const float invf = powf(500000.0f, -(float)j * 0.125f); const float ang = (float)pos * invf;
            float sn, cs; sincos_d(ang, sn, cs); rope[pos * 16 + j] = cs; rope[pos * 16 + 8 + j] = sn; }
        LAS float* scr = (LAS float*)(lds + wave * 16384);
        constexpr int I_IN = 16 * 320, I_SQ = 16 * 32;
        for (int it = gw; it < I_IN + 3 * I_SQ; it += NGW) {
            if (it < I_IN) { const int kb = it / 320, nb = it % 320, n0 = nb * 32, sg = n0 >> 10;
                const int wi = n0 & 1023;
                const int drow = sg == 0 ? ((wi >> 7) * 256 + (wi & 127)) : sg == 1 ? ((wi >> 7) * 256 + 128 + (wi & 127))
                               : (int)((0x9875436210ULL >> (4 * sg)) & 0xFULL) * 1024 + wi;
                p0_transpose_item(w_in, 1024, 10240, WIN, drow, scr, kb * 64, n0, lane); }
            else { const int r = it - I_IN, m = r / I_SQ, q = r % I_SQ, kb = q / 32, nb = q % 32;
                const float* W = m == 0 ? w_a : (m == 1 ? w_b : w_o); bf16_t* WT = m == 0 ? WA : (m == 1 ? WB : WO);
                p0_transpose_item(W, 1024, 1024, WT, nb * 32, scr, kb * 64, nb * 32, lane); }
        }
        for (int m = gw; m < MU; m += NGW) {
            const float* xr = m < MREAL ? x + (size_t)m * DM : (m < MREAL + 16 ? meta + (size_t)(m - MREAL) * DM : nullptr);
            u_row(xr, norm_g, U + (size_t)m * DM, lane, m < MREAL ? rmsx + m : nullptr);
        }
        for (int i = gt; i < 6 * 64 * PADN * 16; i += NGT) { const int run = i / (PADN * 16), q = i % (PADN * 16), a6 = run >> 6, bh = run & 63;
            *(u32x4*)(P + (size_t)a6 * PSTRIDE + (size_t)bh * LP * 128 + (size_t)q * 8) = (u32x4){0u, 0u, 0u, 0u}; }
        __syncthreads();
    }
    SEAM(0);
    if (IN(1)) for (int rep_ = 0; rep_ < NREP(1); ++rep_) {
        if (rep_) grid.sync();
        { const int gw = bx * 8 + wave; if (gw < 320) meta_task(U, WIN, P, lbt, rope, EVG, gw, lane); }
        pg8::Gemm g{U, WIN, MREAL, 6144, 1024}; pg8::StaticOrder S; S.init(MREAL, 6144, G, bx);
        pg8::EpiProj E{P, lbt, rope, EVG};
        pg8::gemm_phase<pg8::EpiProj, pg8::StaticOrder, true, true>(lds, g, S, E);
        __syncthreads();
    }
    SEAM(1);
    if (IN(2)) {
        if (bx < 64 && !(args.flags & 1)) {
            hgrn_seq(lds, P, P + PSTRIDE, P + 2 * PSTRIDE, EVG, OAB, SSQ, hg_g, bx >> 3, bx & 7);
            float* RST = SSQ + (size_t)64 * 8 * SEQ;
            for (int sI = tid; sI < SEQ; sI += 512) { float tot = 0.f;
#pragma unroll
                for (int ww = 0; ww < 8; ++ww) tot += SSQ[((size_t)(bx * 8 + ww)) * SEQ + sI];
                RST[(size_t)bx * SEQ + sI] = __builtin_amdgcn_rsqf(tot * (1.0f / 128.0f) + 1e-6f); }
        }
        const float lam = *lamp;
        LAS unsigned* qslot = (LAS unsigned*)(lds + 131072);
        const int xq = bx & 7;
        if (!(args.flags & 2)) for (;;) {
            __syncthreads();
            if (tid == 0) *qslot = atomicAdd(ctl + 16 * xq, 1u);
            __syncthreads();
            const unsigned idx = *qslot;
            if (idx >= 256u) break;
            const int pass = (int)(idx >> 7), k = (int)(idx & 127u), bhl = k >> 4, qi = k & 15;
            const int qblk = (pass == 0 ? 32 : 16) - qi, bh = 8 * bhl + xq;
            attn_unit(lds, P + 3 * PSTRIDE, P + 4 * PSTRIDE, P + 5 * PSTRIDE, OAB + P3STRIDE, da_g, lam, bh >> 3, bh & 7, qblk);
        }
        __syncthreads();
    }
    SEAM(2);
    if (IN(3)) for (int rep_ = 0; rep_ < NREP(3); ++rep_) {
        if (rep_) grid.sync();
        pg8::Gemm g{U, WIN + (size_t)6144 * 1024, MREAL, 4096, 1024}; pg8::StaticOrder S; S.init(MREAL, 4096, G, bx);
        pg8::EpiGate E{P, OAB, SSQ + (size_t)64 * 8 * SEQ};
        pg8::gemm_phase<pg8::EpiGate, pg8::StaticOrder, true, true>(lds, g, S, E);
        __syncthreads();
    }
    SEAM(3);
    if (IN(4)) for (int rep_ = 0; rep_ < NREP(4); ++rep_) {
        if (rep_) grid.sync();
        bf16_t* Mx = P + 4 * P3STRIDE;
        { pg8::Gemm g{P, WA, MREAL, 1024, 1024}; pg8::StaticOrder S; S.init(MREAL, 1024, G, bx);
          pg8::EpiMix<0> E{Mx, P + 2 * P3STRIDE};
          pg8::gemm_phase<pg8::EpiMix<0>, pg8::StaticOrder, true, true>(lds, g, S, E); }
        __syncthreads();
        { pg8::Gemm g{P + P3STRIDE, WB, MREAL, 1024, 1024}; pg8::StaticOrder S; S.init(MREAL, 1024, G, bx);
          pg8::EpiMix<1> E{Mx, P + 3 * P3STRIDE};
          pg8::gemm_phase<pg8::EpiMix<1>, pg8::StaticOrder, true, true>(lds, g, S, E); }
        __syncthreads();
    }
    SEAM(4);
    if (IN(5)) for (int rep_ = 0; rep_ < NREP(5); ++rep_) {
        if (rep_) grid.sync();
        pg8::Gemm g{P + 4 * P3STRIDE, WO, MREAL, 1024, 1024}; pg8::StaticOrder S; S.init(MREAL, 1024, G, bx);
        pg8::EpiOut E{U, rmsx, ginv, P + 5 * P3STRIDE};
        pg8::gemm_phase<pg8::EpiOut, pg8::StaticOrder, true, true>(lds, g, S, E);
        __syncthreads();
    }
    SEAM(5);
    if (IN(6)) {
        const int gw = bx * 8 + wave, NGW = G * 8;
        const bf16_t* H16 = P + 5 * P3STRIDE;
        f32x4 g0[2], g1[2];
#pragma unroll
        for (int j = 0; j < 2; ++j) { g0[j] = *(const f32x4*)(final_g + j * 512 + lane * 8); g1[j] = *(const f32x4*)(final_g + j * 512 + lane * 8 + 4); }
        for (int m = gw; m < MREAL; m += NGW) {
            const bf16_t* hrow = H16 + (size_t)m * DM; float* orow = args.out + (size_t)m * DM;
            float v[2][8]; float s = 0.f;
#pragma unroll
            for (int j = 0; j < 2; ++j) { const u32x4 hv = *(const u32x4*)(hrow + j * 512 + lane * 8);
                v[j][0] = bflo(hv.x); v[j][1] = bfhi(hv.x); v[j][2] = bflo(hv.y); v[j][3] = bfhi(hv.y); v[j][4] = bflo(hv.z); v[j][5] = bfhi(hv.z); v[j][6] = bflo(hv.w); v[j][7] = bfhi(hv.w);
#pragma unroll
                for (int i = 0; i < 8; ++i) s += v[j][i] * v[j][i]; }
            const float rstd = 1.0f / sqrtf(wave_sum(s) * (1.0f / DM) + 1e-6f);
#pragma unroll
            for (int j = 0; j < 2; ++j) {
                *(f32x4*)(orow + j * 512 + lane * 8) = (f32x4){v[j][0] * rstd * g0[j][0], v[j][1] * rstd * g0[j][1], v[j][2] * rstd * g0[j][2], v[j][3] * rstd * g0[j][3]};
                *(f32x4*)(orow + j * 512 + lane * 8 + 4) = (f32x4){v[j][4] * rstd * g1[j][0], v[j][5] * rstd * g1[j][1], v[j][6] * rstd * g1[j][2], v[j][7] * rstd * g1[j][3]};
            }
        }
    }
#undef IN
#undef SEAM
}

#ifndef MK_LAUNCHES
#define MK_LAUNCHES 1
#endif

extern "C" void kernel_launch(void* const* d_in, const int* in_sizes, int n_in, void* d_out, int out_size, void* d_ws, size_t ws_size, hipStream_t stream) {
    static int grid = 0;
    if (grid == 0) {
        if (n_in != 12 || out_size != MREAL * DM || ws_size < WS_NEED) { fprintf(stderr, "kernel_launch: unexpected shapes (n_in %d out %d ws %zu need %zu)\n", n_in, out_size, ws_size, (size_t)WS_NEED); grid = -1; return; }
        int dev = 0, cus = 0, per_cu = 0;
        hipGetDevice(&dev); hipDeviceGetAttribute(&cus, hipDeviceAttributeMultiprocessorCount, dev);
        if (hipFuncSetAttribute((const void*)mega_fwd, hipFuncAttributeMaxDynamicSharedMemorySize, LDS_BYTES) != hipSuccess) { fprintf(stderr, "kernel_launch: hipFuncSetAttribute failed\n"); grid = -1; return; }
        hipOccupancyMaxActiveBlocksPerMultiprocessor(&per_cu, (const void*)mega_fwd, 512, LDS_BYTES);
        (void)hipGetLastError();
        if (per_cu < 1) per_cu = 1;
        grid = cus;
        fprintf(stderr, "kernel_launch: cus %d per_cu %d grid %d\n", cus, per_cu, grid);
    }
    if (grid < 0) return;
    Args a{};
    for (int i = 0; i < 12; ++i) a.in[i] = (const float*)d_in[i];
    a.out = (float*)d_out; a.ws = (unsigned char*)d_ws;
#if MK_LAUNCHES == 1
    void* kargs[] = {&a};
#ifndef MK_PROBE
#define MK_PROBE 0
#endif
#if MK_PROBE == 0
    a.ph_lo = 0; a.ph_hi = NPH;
    (void)hipMemsetAsync((char*)d_ws + WS_XBAR, 0, 16384, stream);
    hipError_t e = hipLaunchCooperativeKernel((const void*)mega_fwd, dim3(grid), dim3(512), kargs, LDS_BYTES, stream);
    if (e != hipSuccess) fprintf(stderr, "kernel_launch: cooperative launch failed: %s (grid %d)\n", hipGetErrorString(e), grid);
#else
    a.ph_lo = 0; a.ph_hi = MK_PROBE_PH + 1; a.flags = 0;
    (void)hipMemsetAsync((char*)d_ws + WS_XBAR, 0, 16384, stream);
    (void)hipLaunchCooperativeKernel((const void*)mega_fwd, dim3(grid), dim3(512), kargs, LDS_BYTES, stream);
    (void)hipMemsetAsync(d_ws, 0, 512, stream);
    (void)hipMemsetAsync((char*)d_ws + WS_XBAR, 0, 16384, stream);
    a.ph_lo = MK_PROBE_PH; a.ph_hi = MK_PROBE_PH + 1; a.flags = MK_PROBE_FLAGS;
    (void)hipLaunchCooperativeKernel((const void*)mega_fwd, dim3(grid), dim3(512), kargs, LDS_BYTES, stream);
    a.ph_lo = MK_PROBE_PH + 1; a.ph_hi = NPH; a.flags = 0;
    (void)hipMemsetAsync((char*)d_ws + WS_XBAR, 0, 16384, stream);
    (void)hipLaunchCooperativeKernel((const void*)mega_fwd, dim3(grid), dim3(512), kargs, LDS_BYTES, stream);
#endif
#else
    for (int p = 0; p < NPH; ++p) { a.ph_lo = p; a.ph_hi = p + 1; hipLaunchKernelGGL(mega_fwd, dim3(grid), dim3(512), LDS_BYTES, stream, a); }
#endif
}
```

```cpp
#include <hip/hip_runtime.h>
#include <hip/hip_cooperative_groups.h>
#include <cstdio>
#include <cstdint>
#include <type_traits>
namespace cg = cooperative_groups;
namespace pg8 {
#define PG8_LAS __attribute__((address_space(3)))
typedef unsigned short bf16_t;
typedef short bf16x8 __attribute__((ext_vector_type(8)));
typedef float f32x4 __attribute__((ext_vector_type(4)));
typedef unsigned u32x4 __attribute__((ext_vector_type(4)));
constexpr int BM = 256, BK = 64, HALF = 128, HTB = HALF * BK * 2  , STAGE_BYTES = 8 * HTB, NXCD = 8, WGM = 8;

__host__ __device__ __forceinline__ int lds_byte(int r, int c) { const int st = (r >> 4) * 2 + (c >> 5), rr = r & 15, cc = c & 31, ob = rr * 64 + cc * 2; return st * 1024 + (ob ^ (((ob >> 9) & 1) << 5)); }
__host__ __device__ __forceinline__ void stage_rc(int b, int& R, int& C) { const int st = b / 1024, sb = b % 1024, swz = sb ^ (((sb >> 9) & 1) << 5); R = (st >> 1) * 16 + swz / 64; C = (st & 1) * 32 + (swz % 64) / 2; }
__host__ __device__ __forceinline__ int perm32(int rho) { const int n = rho >> 4, i = rho & 15; return 8 * (i >> 2) + 4 * n + (i & 3); }

struct Unit { int pm, pn; };
struct Gemm { const bf16_t* A; const bf16_t* Bt; int M, N, K; };

struct StaticOrder {
    int nM, nN, nwg, G, c;
    __host__ __device__ void init(int M, int N, int G_, int c_) { nM = M / BM; nN = N / BM; nwg = nM * nN; G = G_; c = c_; }
    __host__ __device__ bool next(int i, Unit& u) const {
        const long L = (long)i * G + c; if (L >= nwg) return false;
        int wgid = (int)L; { const int q = nwg / NXCD, r = nwg % NXCD, xcd = wgid % NXCD, off = wgid / NXCD; wgid = (xcd < r ? xcd * (q + 1) : r * (q + 1) + (xcd - r) * q) + off; }
        const int nig = WGM * nN, gid = wgid / nig, fm = gid * WGM, gsz = (nM - fm) < WGM ? (nM - fm) : WGM;
        u.pm = fm + ((wgid % nig) % gsz); u.pn = (wgid % nig) / gsz; return true;
    }
    __device__ __forceinline__ void a_ready(const Unit&) const {}
    __device__ __forceinline__ void done(const Unit&) const {}
};

__device__ __forceinline__ unsigned cvt_pk_bf16(float lo, float hi) { unsigned r; asm volatile("v_cvt_pk_bf16_f32 %0, %1, %2" : "=v"(r) : "v"(lo), "v"(hi)); return r; }
typedef float f32x2 __attribute__((ext_vector_type(2)));
template <class Epi, class Sched, bool ALIGN_EPI = false, bool SP2 = false>
__device__ __forceinline__ void gemm_phase(PG8_LAS unsigned char* lds, const Gemm g, const Sched& S, const Epi& E) {
    const int tid = threadIdx.x, wid = __builtin_amdgcn_readfirstlane(tid >> 6), lane = tid & 63, wr = wid >> 2, wc = wid & 3, fr = lane & 15, fq = lane >> 4;
    const int K = g.K, nt = K / BK;
    unsigned voffA[2], voffB[2];
#pragma unroll
    for (int i = 0; i < 2; ++i) { int R, C; stage_rc(tid * 16 + i * 8192, R, C); const int Rb = Epi::PERM ? ((R & ~31) + perm32(R & 31)) : R;
        voffA[i] = (unsigned)(R * K + C) * 2u; voffB[i] = (unsigned)(Rb * K + C) * 2u; }
    const size_t kstep = (size_t)(BK * 2);
    const size_t hstep = (size_t)HALF * K * 2;
    const size_t tstep = 2 * hstep;
    const unsigned ldsw = (unsigned)wid * 1024u;
    const int aoff = lds_byte(wr * 64 + fr, fq * 8), boff = lds_byte(wc * 32 + fr, fq * 8);
#define PG8_SA(b, h) (((b) * 2 + (h)) * HTB)
#define PG8_SB(b, h) ((4 + (b) * 2 + (h)) * HTB)
#define PG8_STAGE(bufoff, gbase, voff) do { _Pragma("unroll") for (int _i = 0; _i < 2; ++_i) \
        __builtin_amdgcn_global_load_lds((const unsigned*)((const char*)(gbase) + (voff)[_i]), (PG8_LAS unsigned*)(lds + (bufoff) + ldsw + _i * 8192), 16, 0, 0); } while (0)
#define PG8_LDA(dst, b, h) do { _Pragma("unroll") for (int m = 0; m < 4; ++m) _Pragma("unroll") for (int k = 0; k < 2; ++k) dst[m][k] = *(const PG8_LAS bf16x8*)(lds + PG8_SA(b, h) + aoff + m * 2048 + k * 1024); } while (0)
#define PG8_LDB(dst, b, h) do { _Pragma("unroll") for (int n = 0; n < 2; ++n) _Pragma("unroll") for (int k = 0; k < 2; ++k) dst[n][k] = *(const PG8_LAS bf16x8*)(lds + PG8_SB(b, h) + boff + n * 2048 + k * 1024); } while (0)
#define PG8_MMA(ai, bj, At, Bt) do { __builtin_amdgcn_s_setprio(1); _Pragma("unroll") for (int m = 0; m < 4; ++m) _Pragma("unroll") for (int n = 0; n < 2; ++n) _Pragma("unroll") for (int k = 0; k < 2; ++k) \
        acc[ai][bj][m][n] = __builtin_amdgcn_mfma_f32_16x16x32_bf16(Bt[n][k], At[m][k], acc[ai][bj][m][n], 0, 0, 0); __builtin_amdgcn_s_setprio(0); } while (0)
#define PG8_WAIT_V(n) asm volatile("s_waitcnt vmcnt(" #n ")" ::: "memory")
#define PG8_WAIT_L(n) asm volatile("s_waitcnt lgkmcnt(" #n ")" ::: "memory")
#define PG8_BAR __builtin_amdgcn_s_barrier()
#define PG8_SCHED __builtin_amdgcn_sched_barrier(0)
    Unit cur, nxt; int ui = 0;
    if (!S.next(0, cur)) return;
    f32x4 acc[2][2][4][2];
#pragma unroll
    for (int a = 0; a < 2; ++a)
#pragma unroll
        for (int b = 0; b < 2; ++b)
#pragma unroll
            for (int m = 0; m < 4; ++m)
#pragma unroll
                for (int n = 0; n < 2; ++n) acc[a][b][m][n] = (f32x4){0.f, 0.f, 0.f, 0.f};
    bf16x8 At[4][2], B0[2][2], B1[2][2];
    const char* cA = (const char*)g.A + (size_t)cur.pm * tstep; const char* cB = (const char*)g.Bt + (size_t)cur.pn * tstep;
    S.a_ready(cur);
    if constexpr (SP2) {
        PG8_STAGE(PG8_SB(0, 0), cB, voffB); PG8_STAGE(PG8_SB(0, 1), cB + hstep, voffB); PG8_STAGE(PG8_SA(0, 0), cA, voffA); PG8_STAGE(PG8_SA(0, 1), cA + hstep, voffA);
        if (wr == 1) PG8_BAR;
        PG8_WAIT_V(2); PG8_BAR;
        PG8_STAGE(PG8_SB(1, 0), cB + kstep, voffB); PG8_STAGE(PG8_SA(1, 0), cA + kstep, voffA); PG8_STAGE(PG8_SB(1, 1), cB + hstep + kstep, voffB);
        PG8_WAIT_V(6); PG8_BAR;
    } else {
        PG8_STAGE(PG8_SB(0, 0), cB, voffB); PG8_STAGE(PG8_SA(0, 0), cA, voffA); PG8_STAGE(PG8_SB(0, 1), cB + hstep, voffB); PG8_STAGE(PG8_SA(0, 1), cA + hstep, voffA);
        if (wr == 1) PG8_BAR;
        PG8_WAIT_V(4); PG8_BAR;
        PG8_STAGE(PG8_SB(1, 0), cB + kstep, voffB); PG8_STAGE(PG8_SA(1, 0), cA + kstep, voffA); PG8_STAGE(PG8_SB(1, 1), cB + hstep + kstep, voffB);
        PG8_WAIT_V(6); PG8_BAR;
    }
    for (;;) {
        const bool has_next = S.next(ui + 1, nxt);
        const char* nA = has_next ? (const char*)g.A + (size_t)nxt.pm * tstep : cA; const char* nB = has_next ? (const char*)g.Bt + (size_t)nxt.pn * tstep : cB;
        for (int t = 0; t < nt; t += 2) {
            const bool last = (t == nt - 2);
            const char* a1 = cA + (size_t)(t + 1) * kstep;
            const char* a2 = last ? nA : cA + (size_t)(t + 2) * kstep; const char* b2 = last ? nB : cB + (size_t)(t + 2) * kstep;
            const char* a3 = a2 + kstep; const char* b3 = b2 + kstep;
            if (last && has_next) S.a_ready(nxt);
            if constexpr (SP2) {
            PG8_LDB(B0, 0, 0); PG8_LDB(B1, 0, 1); PG8_SCHED; PG8_LDA(At, 0, 0); PG8_STAGE(PG8_SA(1, 1), a1 + hstep, voffA);
            PG8_WAIT_V(8); PG8_WAIT_L(0); PG8_BAR; PG8_MMA(0, 0, At, B0); PG8_MMA(0, 1, At, B1); PG8_BAR; PG8_SCHED;
            PG8_LDA(At, 0, 1); PG8_STAGE(PG8_SB(0, 0), b2, voffB); PG8_STAGE(PG8_SB(0, 1), b2 + hstep, voffB); PG8_STAGE(PG8_SA(0, 0), a2, voffA);
            PG8_WAIT_V(8); PG8_WAIT_L(0); PG8_BAR; PG8_MMA(1, 0, At, B0); PG8_MMA(1, 1, At, B1); PG8_BAR; PG8_SCHED;
            PG8_LDB(B0, 1, 0); PG8_LDB(B1, 1, 1); PG8_SCHED; PG8_LDA(At, 1, 0); PG8_STAGE(PG8_SA(0, 1), a2 + hstep, voffA);
            PG8_WAIT_V(8); PG8_WAIT_L(0); PG8_BAR; PG8_MMA(0, 0, At, B0); PG8_MMA(0, 1, At, B1); PG8_BAR; PG8_SCHED;
            PG8_LDA(At, 1, 1); PG8_STAGE(PG8_SB(1, 0), b3, voffB); PG8_STAGE(PG8_SB(1, 1), b3 + hstep, voffB); PG8_STAGE(PG8_SA(1, 0), a3, voffA);
            PG8_WAIT_V(8); PG8_WAIT_L(0); PG8_BAR; PG8_MMA(1, 0, At, B0); PG8_MMA(1, 1, At, B1); PG8_BAR; PG8_SCHED;
            } else {
            PG8_LDB(B0, 0, 0); PG8_SCHED; PG8_LDA(At, 0, 0); PG8_STAGE(PG8_SA(1, 1), a1 + hstep, voffA);
            PG8_WAIT_L(8); PG8_BAR; PG8_WAIT_L(0); PG8_MMA(0, 0, At, B0); PG8_BAR; PG8_SCHED;
            PG8_LDB(B1, 0, 1); PG8_STAGE(PG8_SB(0, 0), b2, voffB);
            PG8_BAR; PG8_WAIT_L(0); PG8_MMA(0, 1, At, B1); PG8_BAR;
            PG8_LDA(At, 0, 1); PG8_STAGE(PG8_SA(0, 0), a2, voffA);
            PG8_BAR; PG8_WAIT_L(0); PG8_MMA(1, 0, At, B0); PG8_BAR; PG8_SCHED;
            PG8_STAGE(PG8_SB(0, 1), b2 + hstep, voffB);
            PG8_WAIT_V(6); PG8_BAR; PG8_MMA(1, 1, At, B1); PG8_BAR;
            PG8_LDB(B0, 1, 0); PG8_SCHED; PG8_LDA(At, 1, 0); PG8_STAGE(PG8_SA(0, 1), a2 + hstep, voffA);
            PG8_WAIT_L(8); PG8_BAR; PG8_WAIT_L(0); PG8_MMA(0, 0, At, B0); PG8_BAR; PG8_SCHED;
            PG8_LDB(B1, 1, 1); PG8_STAGE(PG8_SB(1, 0), b3, voffB);
            PG8_BAR; PG8_WAIT_L(0); PG8_MMA(0, 1, At, B1); PG8_BAR;
            PG8_LDA(At, 1, 1); PG8_STAGE(PG8_SA(1, 0), a3, voffA);
            PG8_BAR; PG8_WAIT_L(0); PG8_MMA(1, 0, At, B0); PG8_BAR; PG8_SCHED;
            PG8_STAGE(PG8_SB(1, 1), b3 + hstep, voffB);
            PG8_WAIT_V(6); PG8_BAR; PG8_MMA(1, 1, At, B1); PG8_BAR;
            }
        }
        if constexpr (ALIGN_EPI) { if (wr == 0) PG8_BAR; }
        if constexpr (!Epi::AFTER_DRAIN) { E(acc, cur, wr, wc, fr, fq); S.done(cur); }
        if (!has_next) break;
#pragma unroll
        for (int a = 0; a < 2; ++a)
#pragma unroll
            for (int b = 0; b < 2; ++b)
#pragma unroll
                for (int m = 0; m < 4; ++m)
#pragma unroll
                    for (int n = 0; n < 2; ++n) acc[a][b][m][n] = (f32x4){0.f, 0.f, 0.f, 0.f};
        cur = nxt; cA = nA; cB = nB; ++ui;
        if constexpr (ALIGN_EPI) { if (wr == 1) PG8_BAR; }
    }
    PG8_WAIT_V(0);
    if constexpr (!ALIGN_EPI) { if (wr == 0) PG8_BAR; }
    PG8_BAR;
    if constexpr (Epi::AFTER_DRAIN) { E.fused(acc, cur, wr, wc, fr, fq, lds, wid, lane); S.done(cur); }
#undef PG8_SA
#undef PG8_SB
#undef PG8_STAGE
#undef PG8_LDA
#undef PG8_LDB
#undef PG8_MMA
#undef PG8_WAIT_V
#undef PG8_WAIT_L
#undef PG8_BAR
#undef PG8_SCHED
}
}

#define LAS __attribute__((address_space(3)))
typedef unsigned short bf16_t;
typedef short bf16x8 __attribute__((ext_vector_type(8)));
typedef short s16x4 __attribute__((ext_vector_type(4)));
typedef float f32x4 __attribute__((ext_vector_type(4)));
typedef float f32x2v __attribute__((ext_vector_type(2)));
typedef float f32x16 __attribute__((ext_vector_type(16)));
typedef unsigned u32x4 __attribute__((ext_vector_type(4)));
typedef unsigned u32x2 __attribute__((ext_vector_type(2)));
typedef LAS unsigned char* ldsp;

constexpr int NB = 8, SEQ = 4096, DM = 1024, LP = 4224, PADN = 112;
constexpr int MREAL = NB * SEQ;
constexpr int MU = 33024;
constexpr size_t MiB = 1u << 20;
constexpr size_t WS_CTL = 0;
constexpr size_t WS_LB = 4096;
constexpr size_t WS_ROPE = 8192;
constexpr size_t WS_WIN = 1 * MiB;
constexpr size_t WS_WA = 21 * MiB, WS_WB = 23 * MiB, WS_WO = 25 * MiB;
constexpr size_t WS_U = 27 * MiB;
constexpr size_t WS_P = 92 * MiB;
constexpr size_t PSTRIDE = (size_t)NB * LP * DM;
constexpr size_t P3STRIDE = (size_t)MREAL * DM;
constexpr size_t WS_SSQ = 496 * MiB;
constexpr size_t WS_NEED = 506 * MiB;
constexpr float LOG2E = 1.4426950408889634f;
constexpr float QSCALE = 0.125f * LOG2E;
constexpr int LDS_BYTES = 131072 + 1024;

#define LBAR() do { asm volatile("s_waitcnt lgkmcnt(0)" ::: "memory"); __builtin_amdgcn_s_barrier(); asm volatile("" ::: "memory"); } while (0)
__device__ __forceinline__ float wave_sum(float v) {
#pragma unroll
    for (int o = 1; o < 64; o <<= 1) v += __shfl_xor(v, o);
    return v;
}
__device__ __forceinline__ unsigned pk2(float lo, float hi) { return pg8::cvt_pk_bf16(lo, hi); }
__device__ __forceinline__ float bflo(unsigned u) { return __builtin_bit_cast(float, u << 16); }
__device__ __forceinline__ float bfhi(unsigned u) { return __builtin_bit_cast(float, u & 0xffff0000u); }
__device__ __forceinline__ float h2f(unsigned short h) { return (float)__builtin_bit_cast(_Float16, h); }
__device__ __forceinline__ unsigned short f2h(float f) { return __builtin_bit_cast(unsigned short, (_Float16)f); }
__device__ __forceinline__ float fexp2(float x) { return __builtin_amdgcn_exp2f(x); }
__device__ __forceinline__ float mulx(float a, float b) { float r; asm("v_mul_f32_e32 %0, %1, %2" : "=v"(r) : "v"(a), "v"(b)); return r; }
__device__ __forceinline__ float sigmoidf_(float x) { return __builtin_amdgcn_rcpf(1.0f + fexp2(-x * LOG2E)); }

namespace pg8 {
template <int N> __device__ __forceinline__ float row_shr(float v) {
    return __builtin_bit_cast(float, __builtin_amdgcn_update_dpp(0, __builtin_bit_cast(int, v), 0x110 + N, 0xf, 0xf, true));
}
struct EpiProj {
    static constexpr bool PERM = true, AFTER_DRAIN = false;
    bf16_t* P; const float* lb; const float* rope; float* EVG;
    __device__ __forceinline__ void operator()(const f32x4 (&acc)[2][2][4][2], const Unit& u, int wr, int wc, int fr, int fq) const {
        const int lane = fr + 16 * fq;
        if (u.pn < 8) {
            const int head = u.pn, ch0 = 32 * wc + 8 * fq;
            const f32x4 lb0 = *(const f32x4*)(lb + head * 128 + ch0), lb1 = *(const f32x4*)(lb + head * 128 + ch0 + 4);
#pragma unroll
            for (int ai = 0; ai < 2; ++ai) {
                const int rp0 = u.pm * BM + ai * HALF + wr * 64;
                const int bb = rp0 >> 12, s0 = rp0 & 4095, cidx = 2 + (s0 >> 6);
                unsigned qpk[4][4], kpk[4][4]; float qev[4], kev[4];
                float emid[8], el[8], elm[8];
#pragma unroll
                for (int e = 0; e < 8; ++e) {
                    const float lbv = e < 4 ? lb0[e] : lb1[e - 4];
                    float f[4], bcs[4], carry = 0.f, ref = 0.f;
#pragma unroll
                    for (int m = 0; m < 4; ++m) {
                        f[m] = lbv + (1.0f - lbv) * sigmoidf_(acc[ai][1][m][e >> 2][e & 3]);
                        float v = __logf(f[m]);
                        v += row_shr<1>(v); v += row_shr<2>(v); v += row_shr<4>(v); v += row_shr<8>(v);
                        v += carry; bcs[m] = v;
                        carry = __shfl(v, (lane & 48) | 15);
                        if (m == 1) ref = carry;
                    }
                    const float bl = carry;
                    emid[e] = fexp2(ref * LOG2E); el[e] = fexp2(bl * LOG2E); elm[e] = fexp2(fmaxf(bl - ref, -100.f) * LOG2E);
#pragma unroll
                    for (int m = 0; m < 4; ++m) {
                        const float d = fminf(fmaxf(bcs[m] - ref, -80.f), 80.f);
                        const float e1 = fexp2(d * LOG2E), e2 = __builtin_amdgcn_rcpf(e1);
                        const float qe = acc[ai][0][m][e >> 2][e & 3] * e1, ke = (1.0f - f[m]) * e2;
                        if (e & 1) { qpk[m][e >> 1] = cvt_pk_bf16(qev[m], qe); kpk[m][e >> 1] = cvt_pk_bf16(kev[m], ke); }
                        else { qev[m] = qe; kev[m] = ke; }
                    }
                }
#pragma unroll
                for (int m = 0; m < 4; ++m) {
                    const size_t off = ((size_t)(bb * 8 + head) * LP + 128 + s0 + m * 16 + fr) * 128 + ch0;
                    *(u32x4*)(P + off) = (u32x4){qpk[m][0], qpk[m][1], qpk[m][2], qpk[m][3]};
                    *(u32x4*)(P + PSTRIDE + off) = (u32x4){kpk[m][0], kpk[m][1], kpk[m][2], kpk[m][3]};
                }
                if (fr == 15) {
                    float* ev = EVG + ((size_t)((bb * 8 + head) * 66 + cidx)) * 384 + ch0;
                    *(f32x4*)(ev) = (f32x4){emid[0], emid[1], emid[2], emid[3]}; *(f32x4*)(ev + 4) = (f32x4){emid[4], emid[5], emid[6], emid[7]};
                    *(f32x4*)(ev + 128) = (f32x4){el[0], el[1], el[2], el[3]}; *(f32x4*)(ev + 132) = (f32x4){el[4], el[5], el[6], el[7]};
                    *(f32x4*)(ev + 256) = (f32x4){elm[0], elm[1], elm[2], elm[3]}; *(f32x4*)(ev + 260) = (f32x4){elm[4], elm[5], elm[6], elm[7]};
                }
            }
            return;
        }
        const int seg = 2 + ((u.pn - 8) >> 2), cseg = ((u.pn - 8) & 3) * BM;
        bf16_t* base = P + (size_t)seg * PSTRIDE;
        const bool ropewave = ((seg == 3) || (seg == 4)) && ((wc & 1) == 0);
#pragma unroll
        for (int ai = 0; ai < 2; ++ai)
#pragma unroll
            for (int m = 0; m < 4; ++m) {
                const int rp = u.pm * BM + ai * HALF + wr * 64 + m * 16 + fr;
                const int bb = rp >> 12, s = rp & 4095;
                const int pos = 16 + s;
#pragma unroll
                for (int bj = 0; bj < 2; ++bj) {
                    const int c0 = cseg + bj * HALF + wc * 32 + 8 * fq;
                    float x[8];
#pragma unroll
                    for (int i = 0; i < 4; ++i) { x[i] = acc[ai][bj][m][0][i]; x[4 + i] = acc[ai][bj][m][1][i]; }
                    if (ropewave) {
                        float p[8];
#pragma unroll
                        for (int i = 0; i < 8; ++i) p[i] = __shfl_xor(x[i], 16);
                        if (fq < 2) {
                            const float* rt = rope + (size_t)pos * 16;
                            const f32x4 c0v = *(const f32x4*)(rt), c1v = *(const f32x4*)(rt + 4), s0v = *(const f32x4*)(rt + 8), s1v = *(const f32x4*)(rt + 12);
                            const float sg = fq == 0 ? -1.0f : 1.0f;
#pragma unroll
                            for (int i = 0; i < 8; ++i) { const float cs = i < 4 ? c0v[i] : c1v[i - 4], sn = i < 4 ? s0v[i] : s1v[i - 4];
                                x[i] = x[i] * cs + sg * p[i] * sn; }
                        }
                    }
                    if (seg == 3) {
#pragma unroll
                        for (int i = 0; i < 8; ++i) x[i] *= QSCALE;
                    }
                    u32x4 w; w.x = cvt_pk_bf16(x[0], x[1]); w.y = cvt_pk_bf16(x[2], x[3]); w.z = cvt_pk_bf16(x[4], x[5]); w.w = cvt_pk_bf16(x[6], x[7]);
                    *(u32x4*)(base + ((size_t)(bb * 8 + (c0 >> 7)) * LP + 128 + s) * 128 + (c0 & 127)) = w;
                }
            }
    }
};
struct EpiGate {
    static constexpr bool PERM = true, AFTER_DRAIN = false;
    bf16_t* T; const bf16_t* OAB; const float* RST;
    __device__ __forceinline__ void operator()(const f32x4 (&acc)[2][2][4][2], const Unit& u, int wr, int wc, int fr, int fq) const {
        const int colt = u.pn * BM, seg = colt >> 10, cseg = colt & 1023;
        bf16_t* base = T + (size_t)seg * P3STRIDE;
        const bf16_t* ob = OAB + (size_t)(seg & 1) * P3STRIDE;
#pragma unroll
        for (int ai = 0; ai < 2; ++ai) {
            u32x4 ov[4][2]; float rn[4][2];
            if (seg < 2) {
#pragma unroll
                for (int m = 0; m < 4; ++m)
#pragma unroll
                    for (int bj = 0; bj < 2; ++bj) {
                        const int rp = u.pm * BM + ai * HALF + wr * 64 + m * 16 + fr, c0 = cseg + bj * HALF + wc * 32 + 8 * fq;
                        ov[m][bj] = *(const u32x4*)(ob + (size_t)rp * DM + c0);
                        rn[m][bj] = seg == 0 ? RST[(size_t)((rp >> 12) * 8 + (c0 >> 7)) * SEQ + (rp & 4095)] : 1.0f;
                    }
            }
#pragma unroll
            for (int m = 0; m < 4; ++m) {
                const int rp = u.pm * BM + ai * HALF + wr * 64 + m * 16 + fr;
#pragma unroll
                for (int bj = 0; bj < 2; ++bj) {
                    const int c0 = cseg + bj * HALF + wc * 32 + 8 * fq;
                    const size_t off = (size_t)rp * DM + c0;
                    float x[8];
#pragma unroll
                    for (int i = 0; i < 4; ++i) { x[i] = acc[ai][bj][m][0][i]; x[4 + i] = acc[ai][bj][m][1][i]; }
                    if (seg < 2) {
                        const u32x4 o = ov[m][bj];
                        const float ovv[8] = {bflo(o.x), bfhi(o.x), bflo(o.y), bfhi(o.y), bflo(o.z), bfhi(o.z), bflo(o.w), bfhi(o.w)};
#pragma unroll
                        for (int i = 0; i < 8; ++i) x[i] = mulx(mulx(x[i], sigmoidf_(x[i])), mulx(ovv[i], rn[m][bj]));
                    } else {
#pragma unroll
                        for (int i = 0; i < 8; ++i) x[i] = sigmoidf_(x[i]);
                    }
                    u32x4 w; w.x = cvt_pk_bf16(x[0], x[1]); w.y = cvt_pk_bf16(x[2], x[3]); w.z = cvt_pk_bf16(x[4], x[5]); w.w = cvt_pk_bf16(x[6], x[7]);
                    *(u32x4*)(base + off) = w;
                }
            }
        }
    }
};
template <int STEP> struct EpiMix {
    static constexpr bool PERM = true, AFTER_DRAIN = false;
    bf16_t* M; const bf16_t* SG;
    __device__ __forceinline__ void operator()(const f32x4 (&acc)[2][2][4][2], const Unit& u, int wr, int wc, int fr, int fq) const {
        const int colt = u.pn * BM;
#pragma unroll
        for (int ai = 0; ai < 2; ++ai) {
            u32x4 gq[4][2], pq[4][2];
#pragma unroll
            for (int m = 0; m < 4; ++m)
#pragma unroll
                for (int bj = 0; bj < 2; ++bj) {
                    const size_t off = (size_t)(u.pm * BM + ai * HALF + wr * 64 + m * 16 + fr) * DM + colt + bj * HALF + wc * 32 + 8 * fq;
                    gq[m][bj] = *(const u32x4*)(SG + off);
                    if (STEP == 1) pq[m][bj] = *(const u32x4*)(M + off);
                }
#pragma unroll
            for (int m = 0; m < 4; ++m)
#pragma unroll
                for (int bj = 0; bj < 2; ++bj) {
                    const size_t off = (size_t)(u.pm * BM + ai * HALF + wr * 64 + m * 16 + fr) * DM + colt + bj * HALF + wc * 32 + 8 * fq;
                    float x[8];
#pragma unroll
                    for (int i = 0; i < 4; ++i) { x[i] = acc[ai][bj][m][0][i]; x[4 + i] = acc[ai][bj][m][1][i]; }
                    const u32x4 g = gq[m][bj];
                    const float gv[8] = {bflo(g.x), bfhi(g.x), bflo(g.y), bfhi(g.y), bflo(g.z), bfhi(g.z), bflo(g.w), bfhi(g.w)};
#pragma unroll
                    for (int i = 0; i < 8; ++i) x[i] = mulx(x[i], gv[i]);
                    if (STEP == 1) {
                        const u32x4 p = pq[m][bj];
                        const float pv[8] = {bflo(p.x), bfhi(p.x), bflo(p.y), bfhi(p.y), bflo(p.z), bfhi(p.z), bflo(p.w), bfhi(p.w)};
#pragma unroll
                        for (int i = 0; i < 8; ++i) x[i] += pv[i];
                    }
                    u32x4 w; w.x = cvt_pk_bf16(x[0], x[1]); w.y = cvt_pk_bf16(x[2], x[3]); w.z = cvt_pk_bf16(x[4], x[5]); w.w = cvt_pk_bf16(x[6], x[7]);
                    *(u32x4*)(M + off) = w;
                }
        }
    }
};
struct EpiOut {
    static constexpr bool PERM = true, AFTER_DRAIN = false;
    const bf16_t* Ub; const float* rmsx; const float* ginv; bf16_t* H;
    __device__ __forceinline__ void operator()(const f32x4 (&acc)[2][2][4][2], const Unit& u, int wr, int wc, int fr, int fq) const {
        f32x4 gi[2][2];
#pragma unroll
        for (int bj = 0; bj < 2; ++bj) { const int c0 = u.pn * BM + bj * HALF + wc * 32 + 8 * fq; gi[bj][0] = *(const f32x4*)(ginv + c0); gi[bj][1] = *(const f32x4*)(ginv + c0 + 4); }
#pragma unroll
        for (int ai = 0; ai < 2; ++ai) {
            u32x4 uq[4][2]; float rm[4];
#pragma unroll
            for (int m = 0; m < 4; ++m) {
                const int rp = u.pm * BM + ai * HALF + wr * 64 + m * 16 + fr;
                rm[m] = rmsx[rp];
#pragma unroll
                for (int bj = 0; bj < 2; ++bj) uq[m][bj] = *(const u32x4*)(Ub + (size_t)rp * DM + u.pn * BM + bj * HALF + wc * 32 + 8 * fq);
            }
#pragma unroll
            for (int m = 0; m < 4; ++m) {
                const int rp = u.pm * BM + ai * HALF + wr * 64 + m * 16 + fr;
#pragma unroll
                for (int bj = 0; bj < 2; ++bj) {
                    const size_t off = (size_t)rp * DM + u.pn * BM + bj * HALF + wc * 32 + 8 * fq;
                    const u32x4 uv = uq[m][bj];
                    const f32x4 x0 = (f32x4){bflo(uv.x), bfhi(uv.x), bflo(uv.y), bfhi(uv.y)} * gi[bj][0] * rm[m] + acc[ai][bj][m][0], x1 = (f32x4){bflo(uv.z), bfhi(uv.z), bflo(uv.w), bfhi(uv.w)} * gi[bj][1] * rm[m] + acc[ai][bj][m][1];
                    u32x4 w; w.x = cvt_pk_bf16(x0[0], x0[1]); w.y = cvt_pk_bf16(x0[2], x0[3]); w.z = cvt_pk_bf16(x1[0], x1[1]); w.w = cvt_pk_bf16(x1[2], x1[3]);
                    *(u32x4*)(H + off) = w;
                }
            }
        }
    }
};
}

__device__ __forceinline__ void p0_transpose_item(const float* W, int K, int N, bf16_t* WT, int dst_row0, LAS float* scr, int k0, int n0, int lane) {
#pragma unroll
    for (int i = 0; i < 8; ++i) { const int kk = 8 * i + (lane >> 3), c4 = (lane & 7) * 4;
        const f32x4 v = *(const f32x4*)(W + (size_t)(k0 + kk) * N + n0 + c4);
        scr[kk * 33 + c4] = v.x; scr[kk * 33 + c4 + 1] = v.y; scr[kk * 33 + c4 + 2] = v.z; scr[kk * 33 + c4 + 3] = v.w; }
    asm volatile("s_waitcnt lgkmcnt(0)" ::: "memory");
    const int c = lane & 7;
#pragma unroll
    for (int j = 0; j < 4; ++j) { const int n = (lane >> 3) + 8 * j; const LAS float* s = scr + (8 * c) * 33 + n;
        u32x4 o; o.x = pk2(s[0 * 33], s[1 * 33]); o.y = pk2(s[2 * 33], s[3 * 33]); o.z = pk2(s[4 * 33], s[5 * 33]); o.w = pk2(s[6 * 33], s[7 * 33]);
        *(u32x4*)(WT + (size_t)(dst_row0 + n) * K + k0 + 8 * c) = o; }
    asm volatile("s_waitcnt lgkmcnt(0)" ::: "memory");
}
__device__ __forceinline__ void u_row(const float* xrow, const float* g, bf16_t* orow, int lane, float* rinv) {
    u32x2* o8 = (u32x2*)orow + lane;
    if (!xrow) {
#pragma unroll
        for (int j = 0; j < 4; ++j) o8[64 * j] = (u32x2){0u, 0u};
        return;
    }
    const f32x4* xr = (const f32x4*)xrow + lane; const f32x4* gr = (const f32x4*)g + lane;
    f32x4 v[4]; float s = 0.f;
#pragma unroll
    for (int j = 0; j < 4; ++j) { v[j] = xr[64 * j]; s += (v[j].x * v[j].x + v[j].y * v[j].y) + (v[j].z * v[j].z + v[j].w * v[j].w); }
    const float rms = sqrtf(wave_sum(s) * (1.0f / DM) + 1e-6f), rstd = 1.0f / rms;
    if (rinv && lane == 0) *rinv = rms;
#pragma unroll
    for (int j = 0; j < 4; ++j) { const f32x4 gv = gr[64 * j];
        o8[64 * j] = (u32x2){pk2(v[j].x * rstd * gv.x, v[j].y * rstd * gv.y), pk2(v[j].z * rstd * gv.z, v[j].w * rstd * gv.w)}; }
}
__device__ __forceinline__ void sincos_d(float af, float& sn, float& cs) {
    const double a = (double)af;
    const double k = __builtin_rint(a * 0.15915494309189535);
    const double r = a - k * 6.283185307179586;
    const double r2 = r * r;
    double s = 0.0, c = 0.0;
    double ts = 1.0, tc = 1.0;
#pragma unroll
    for (int n = 0; n < 16; ++n) {
        s += ts; c += tc;
        ts = -ts * r2 / (double)((2 * n + 2) * (2 * n + 3));
        tc = -tc * r2 / (double)((2 * n + 1) * (2 * n + 2));
    }
    sn = (float)(s * r); cs = (float)c;
}

constexpr size_t WS_EV = 489 * MiB;
__device__ __forceinline__ void hgrn_prep_unit(ldsp lds, bf16_t* HQ, bf16_t* LF, float* EVG, int b, int c, int h, int par) {
    const int tid = threadIdx.x, lane = tid & 63, w = __builtin_amdgcn_readfirstlane(tid >> 6);
    const size_t go0 = ((size_t)b * LP + 64 * c + 8 * w) * DM + h * 128 + 2 * lane;
    unsigned qv[8], lv[8];
#pragma unroll
    for (int i = 0; i < 8; ++i) { qv[i] = *(const unsigned*)(HQ + go0 + (size_t)i * DM); lv[i] = *(const unsigned*)(LF + go0 + (size_t)i * DM); }
    float b0[8], b1[8], r0 = 0.f, r1 = 0.f;
#pragma unroll
    for (int i = 0; i < 8; ++i) { r0 += h2f((unsigned short)(lv[i] & 0xffffu)); r1 += h2f((unsigned short)(lv[i] >> 16)); b0[i] = r0; b1[i] = r1; }
    ldsp wt = lds + par * 4096;
    *(LAS f32x2v*)(wt + (w * 128 + 2 * lane) * 4) = (f32x2v){r0, r1};
    LBAR();
    float pre0 = 0.f, pre1 = 0.f, ref0 = 0.f, ref1 = 0.f, bl0 = 0.f, bl1 = 0.f;
#pragma unroll
    for (int ww = 0; ww < 8; ++ww) { const f32x2v t = *(const LAS f32x2v*)(wt + (ww * 128 + 2 * lane) * 4);
        if (ww < w) { pre0 += t.x; pre1 += t.y; } if (ww < 4) { ref0 += t.x; ref1 += t.y; } bl0 += t.x; bl1 += t.y; }
    if (w == 0) {
        float* ev = EVG + ((size_t)((b * 8 + h) * 66 + c)) * 384 + 2 * lane;
        *(f32x2v*)(ev) = (f32x2v){fexp2(ref0 * LOG2E), fexp2(ref1 * LOG2E)};
        *(f32x2v*)(ev + 128) = (f32x2v){fexp2(bl0 * LOG2E), fexp2(bl1 * LOG2E)};
        *(f32x2v*)(ev + 256) = (f32x2v){fexp2(fmaxf(bl0 - ref0, -100.f) * LOG2E), fexp2(fmaxf(bl1 - ref1, -100.f) * LOG2E)};
    }
#pragma unroll
    for (int i = 0; i < 8; ++i) {
        const float d0 = fminf(fmaxf(pre0 + b0[i] - ref0, -80.f), 80.f), d1 = fminf(fmaxf(pre1 + b1[i] - ref1, -80.f), 80.f);
        const float e10 = fexp2(d0 * LOG2E), e11 = fexp2(d1 * LOG2E);
        const float e20 = __builtin_amdgcn_rcpf(e10), e21 = __builtin_amdgcn_rcpf(e11);
        const float k0 = 1.0f - fexp2(h2f((unsigned short)(lv[i] & 0xffffu)) * LOG2E), k1 = 1.0f - fexp2(h2f((unsigned short)(lv[i] >> 16)) * LOG2E);
        *(unsigned*)(HQ + go0 + (size_t)i * DM) = pk2(bflo(qv[i]) * e10, bfhi(qv[i]) * e11);
        *(unsigned*)(LF + go0 + (size_t)i * DM) = pk2(k0 * e20, k1 * e21);
    }
}

constexpr int HG_STR = 272;
constexpr int HG_QE = 0;
constexpr int HG_KE = HG_QE + 64 * HG_STR;
constexpr int HG_V = HG_KE + 64 * HG_STR;
constexpr int HG_A1 = HG_V + 64 * HG_STR, HG_TSTR = 144;
constexpr int HG_EV = HG_A1 + 64 * HG_TSTR;
constexpr int HG_SS = HG_EV + 3 * 128 * 4;
constexpr int HG_END = HG_SS + 8 * 64 * 4;
static_assert(HG_END <= 131072, "HGRN LDS");
typedef short v4i16_t __attribute__((ext_vector_type(4)));
__device__ __forceinline__ s16x4 vtr(ldsp p) { return __builtin_bit_cast(s16x4, __builtin_amdgcn_ds_read_tr16_b64_v4i16((LAS v4i16_t*)p)); }

__device__ __forceinline__ void hgrn_seq(ldsp lds, const bf16_t* HQ, const bf16_t* LF, const bf16_t* HI, const float* EVG, bf16_t* OA, float* SSQ, const float* gA, int b, int h) {
    const int tid = threadIdx.x, lane = tid & 63, w = __builtin_amdgcn_readfirstlane(tid >> 6), fr = lane & 15, fq = lane >> 4;
    const size_t rowb = (size_t)(b * 8 + h) * LP;
    f32x4 S[8];
#pragma unroll
    for (int i = 0; i < 8; ++i) S[i] = (f32x4){0.f, 0.f, 0.f, 0.f};
    const int srow = tid >> 3, sch = (tid & 7) * 2;
    const size_t gcol = (size_t)sch * 8;
    u32x4 rq0, rq1, rk0, rk1, rv0, rv1; f32x4 rev = (f32x4){0.f, 0.f, 0.f, 0.f};
#define HG_LOAD(c) do { const size_t go = (rowb + 64 * (c) + srow) * 128 + gcol; \
        rq0 = *(const u32x4*)(HQ + go); rq1 = *(const u32x4*)(HQ + go + 8); rk0 = *(const u32x4*)(LF + go); rk1 = *(const u32x4*)(LF + go + 8); \
        rv0 = *(const u32x4*)(HI + go); rv1 = *(const u32x4*)(HI + go + 8); \
        if (tid < 96) rev = *(const f32x4*)(EVG + ((size_t)((b * 8 + h) * 66 + (c))) * 384 + tid * 4); } while (0)
    HG_LOAD(1);
    const float gv = gA[16 * w + fr];
    const int trq = fr >> 2, trp = fr & 3;
    for (int c = 1; c <= 65; ++c) {
        LBAR();
        *(LAS u32x4*)(lds + HG_QE + srow * HG_STR + sch * 16) = rq0; *(LAS u32x4*)(lds + HG_QE + srow * HG_STR + sch * 16 + 16) = rq1;
        *(LAS u32x4*)(lds + HG_KE + srow * HG_STR + sch * 16) = rk0; *(LAS u32x4*)(lds + HG_KE + srow * HG_STR + sch * 16 + 16) = rk1;
        *(LAS u32x4*)(lds + HG_V + srow * HG_STR + sch * 16) = rv0; *(LAS u32x4*)(lds + HG_V + srow * HG_STR + sch * 16 + 16) = rv1;
        if (tid < 96) *(LAS f32x4*)(lds + HG_EV + tid * 16) = rev;
        if (c < 65) HG_LOAD(c + 1);
        LBAR();
        {
            const int ti = w >> 1;
#pragma unroll
            for (int e = 0; e < 2; ++e) {
                const int si = 2 * (w & 1) + e;
                f32x4 a = (f32x4){0.f, 0.f, 0.f, 0.f};
                if (si <= ti) {
#pragma unroll
                    for (int ks = 0; ks < 4; ++ks) {
                        const bf16x8 qa = *(const LAS bf16x8*)(lds + HG_QE + (16 * ti + fr) * HG_STR + (32 * ks + 8 * fq) * 2);
                        const bf16x8 kb = *(const LAS bf16x8*)(lds + HG_KE + (16 * si + fr) * HG_STR + (32 * ks + 8 * fq) * 2);
                        a = __builtin_amdgcn_mfma_f32_16x16x32_bf16(qa, kb, a, 0, 0, 0);
                    }
                }
                const int s = 16 * si + fr;
#pragma unroll
                for (int i = 0; i < 4; ++i) { const int t = 16 * ti + 4 * fq + i; const float val = (s <= t) ? a[i] : 0.f;
                    *(LAS unsigned short*)(lds + HG_A1 + t * HG_TSTR + 2 * s) = (unsigned short)(pk2(val, 0.f) & 0xffffu); }
            }
        }
        bf16x8 vf[2];
#pragma unroll
        for (int ks = 0; ks < 2; ++ks) {
            const s16x4 lo = vtr(lds + HG_V + (32 * ks + 8 * fq + trq) * HG_STR + (16 * w + 4 * trp) * 2);
            const s16x4 hi = vtr(lds + HG_V + (32 * ks + 8 * fq + 4 + trq) * HG_STR + (16 * w + 4 * trp) * 2);
            vf[ks] = __builtin_shufflevector(lo, hi, 0, 1, 2, 3, 4, 5, 6, 7);
        }
        bf16x8 sp[4];
#pragma unroll
        for (int a = 0; a < 4; ++a) {
            const f32x4 e0 = *(const LAS f32x4*)(lds + HG_EV + (32 * a + 4 * fq) * 4), e1 = *(const LAS f32x4*)(lds + HG_EV + (32 * a + 16 + 4 * fq) * 4);
            const f32x4 x0 = S[2 * a] * e0, x1 = S[2 * a + 1] * e1;
            const u32x4 pk = (u32x4){pk2(x0[0], x0[1]), pk2(x0[2], x0[3]), pk2(x1[0], x1[1]), pk2(x1[2], x1[3])};
            sp[a] = __builtin_bit_cast(bf16x8, pk);
        }
#pragma unroll
        for (int dt = 0; dt < 8; ++dt) {
            f32x4 acc = (f32x4){0.f, 0.f, 0.f, 0.f};
#pragma unroll
            for (int ks = 0; ks < 2; ++ks) {
                const s16x4 lo = vtr(lds + HG_KE + (32 * ks + 8 * fq + trq) * HG_STR + (16 * dt + 4 * trp) * 2);
                const s16x4 hi = vtr(lds + HG_KE + (32 * ks + 8 * fq + 4 + trq) * HG_STR + (16 * dt + 4 * trp) * 2);
                const bf16x8 kf = __builtin_shufflevector(lo, hi, 0, 1, 2, 3, 4, 5, 6, 7);
                acc = __builtin_amdgcn_mfma_f32_16x16x32_bf16(kf, vf[ks], acc, 0, 0, 0);
            }
            const f32x4 el = *(const LAS f32x4*)(lds + HG_EV + (128 + 16 * dt + 4 * fq) * 4), elm = *(const LAS f32x4*)(lds + HG_EV + (256 + 16 * dt + 4 * fq) * 4);
            S[dt] = S[dt] * el + acc * elm;
        }
        LBAR();
        f32x4 o[4];
#pragma unroll
        for (int tt = 0; tt < 4; ++tt) {
            f32x4 acc = (f32x4){0.f, 0.f, 0.f, 0.f};
#pragma unroll
            for (int ks = 0; ks < 2; ++ks) {
                const bf16x8 af = *(const LAS bf16x8*)(lds + HG_A1 + (16 * tt + fr) * HG_TSTR + (32 * ks + 8 * fq) * 2);
                acc = __builtin_amdgcn_mfma_f32_16x16x32_bf16(af, vf[ks], acc, 0, 0, 0);
            }
#pragma unroll
            for (int a = 0; a < 4; ++a) {
                const s16x4 lo = *(const LAS s16x4*)(lds + HG_QE + (16 * tt + fr) * HG_STR + (32 * a + 4 * fq) * 2);
                const s16x4 hi = *(const LAS s16x4*)(lds + HG_QE + (16 * tt + fr) * HG_STR + (32 * a + 16 + 4 * fq) * 2);
                const bf16x8 qa = __builtin_shufflevector(lo, hi, 0, 1, 2, 3, 4, 5, 6, 7);
                acc = __builtin_amdgcn_mfma_f32_16x16x32_bf16(qa, sp[a], acc, 0, 0, 0);
            }
            o[tt] = acc;
        }
        if (c >= 2) {
#pragma unroll
            for (int tt = 0; tt < 4; ++tt) {
                f32x4 q = o[tt] * o[tt];
#pragma unroll
                for (int sh = 1; sh < 16; sh <<= 1) { q[0] += __shfl_xor(q[0], sh); q[1] += __shfl_xor(q[1], sh); q[2] += __shfl_xor(q[2], sh); q[3] += __shfl_xor(q[3], sh); }
                const int s0 = 64 * c + 16 * tt + 4 * fq - 128;
                if (fr == 0) *(f32x4*)(SSQ + ((size_t)((b * 8 + h) * 8 + w)) * SEQ + s0) = q;
#pragma unroll
                for (int i = 0; i < 4; ++i)
                    OA[((size_t)b * SEQ + s0 + i) * DM + h * 128 + 16 * w + fr] = (bf16_t)(pk2(o[tt][i] * gv, 0.f) & 0xffffu);
            }
        }
    }
#undef HG_LOAD
    __syncthreads();
}

constexpr int AT_SLOT = 65536, AT_VOFF = 32768;
constexpr int AT_X = 0;
__device__ __forceinline__ int crow(int r, int hi) { return (r & 3) + 8 * (r >> 2) + 4 * hi; }
typedef __bf16 bf16x2_t __attribute__((ext_vector_type(2)));
__device__ __forceinline__ unsigned cvtpk_s(float lo, float hi) { f32x2v v = {lo, hi}; bf16x2_t bb = __builtin_convertvector(v, bf16x2_t); return __builtin_bit_cast(unsigned, bb); }
__device__ __forceinline__ float max3f(float a, float b, float c) { return fmaxf(fmaxf(a, b), c); }
constexpr float AT_THR = 8.0f;

__device__ __forceinline__ void attn_unit(ldsp lds, const bf16_t* AQ, const bf16_t* AK, const bf16_t* AV, bf16_t* OB, const float* gB, float lam, int b, int h, int qblk) {
    const int tid = threadIdx.x, lane = tid & 63, w = __builtin_amdgcn_readfirstlane(tid >> 6), comp = w >> 2, qsub = w & 3, r = lane & 31, hi = lane >> 5;
    const int L0 = qblk * 128;
    const size_t rowb = (size_t)(b * 8 + h) * LP;
    const int qL = L0 + 32 * qsub + r;
    int gk[4], gv[4];
    {
        const int l4 = lane >> 4, p16 = lane & 15;
#pragma unroll
        for (int i = 0; i < 4; ++i) { const int row = 16 * w + 4 * i + l4;
            gk[i] = row * 128 + ((p16 ^ (row & 15)) << 3);
            gv[i] = row * 128 + ((p16 ^ ((row & 3) << 2)) << 3); }
    }
#define AT_DMA(j) do { const bf16_t* kb_ = AK + (rowb + 128 * (j)) * 128; const bf16_t* vb_ = AV + (rowb + 128 * (j)) * 128; const int so_ = ((j) & 1) * AT_SLOT + 4 * w * 1024; \
        _Pragma("unroll") for (int i_ = 0; i_ < 4; ++i_) { \
            __builtin_amdgcn_global_load_lds((const unsigned*)(kb_ + gk[i_]), (LAS unsigned*)(lds + so_ + i_ * 1024), 16, 0, 0); \
            __builtin_amdgcn_global_load_lds((const unsigned*)(vb_ + gv[i_]), (LAS unsigned*)(lds + so_ + AT_VOFF + i_ * 1024), 16, 0, 0); } } while (0)
    LBAR();
    if (w >= 6) AT_DMA(0);
    AT_DMA(1);
    bf16x8 qf[4];
    {
        const bf16_t* qp = AQ + (rowb + qL) * 128 + comp * 64 + 8 * hi;
#pragma unroll
        for (int ks = 0; ks < 4; ++ks) qf[ks] = *(const bf16x8*)(qp + 16 * ks);
    }
    f32x16 o[4];
#pragma unroll
    for (int t4 = 0; t4 < 4; ++t4)
#pragma unroll
        for (int i = 0; i < 16; ++i) o[t4][i] = 0.f;
    float mhat = 0.f, lrun = 0.f;
    int kaddr[4], vaddr[4];
    {
        const int q_ = (lane & 15) >> 2, p_ = lane & 3, g1 = (lane >> 4) & 1;
#pragma unroll
        for (int ks = 0; ks < 4; ++ks) kaddr[ks] = r * 256 + (((comp * 8 + 2 * ks + hi) ^ (r & 15)) << 4);
#pragma unroll
        for (int t4 = 0; t4 < 4; ++t4) vaddr[t4] = AT_VOFF + (4 * hi + q_) * 256 + ((((t4 ^ q_) << 2) + g1 * 2 + (p_ >> 1)) << 4) + (p_ & 1) * 8;
    }
    asm volatile("s_waitcnt vmcnt(0)" ::: "memory");
    LBAR();
    {
        f32x16 s3;
#pragma unroll
        for (int i = 0; i < 16; ++i) s3[i] = 0.f;
#pragma unroll
        for (int ks = 0; ks < 4; ++ks) { const bf16x8 kf = *(const LAS bf16x8*)(lds + kaddr[ks] + 3 * 8192); s3 = __builtin_amdgcn_mfma_f32_32x32x16_bf16(kf, qf[ks], s3, 0, 0, 0); }
#pragma unroll
        for (int i = 0; i < 16; ++i) if (96 + crow(i, hi) < PADN) s3[i] = -1e30f;
        float rm = s3[0];
#pragma unroll
        for (int i = 1; i < 16; ++i) rm = fmaxf(rm, s3[i]);
        rm = fmaxf(rm, __shfl_xor(rm, 32));
        mhat = rm;
        float ls = 0.f;
#pragma unroll
        for (int i = 0; i < 16; ++i) { s3[i] = fexp2(s3[i] - rm); ls += s3[i]; }
        lrun = ls;
        u32x4 p0 = (u32x4){cvtpk_s(s3[0], s3[1]), cvtpk_s(s3[2], s3[3]), cvtpk_s(s3[4], s3[5]), cvtpk_s(s3[6], s3[7])};
        u32x4 p1 = (u32x4){cvtpk_s(s3[8], s3[9]), cvtpk_s(s3[10], s3[11]), cvtpk_s(s3[12], s3[13]), cvtpk_s(s3[14], s3[15])};
        const bf16x8 pa0 = __builtin_bit_cast(bf16x8, p0), pa1 = __builtin_bit_cast(bf16x8, p1);
#pragma unroll
        for (int t4 = 0; t4 < 4; ++t4) {
            const s16x4 lo0 = vtr(lds + vaddr[t4] + 96 * 256), hv0 = vtr(lds + vaddr[t4] + 104 * 256), lo1 = vtr(lds + vaddr[t4] + 112 * 256), hv1 = vtr(lds + vaddr[t4] + 120 * 256);
            const bf16x8 vf0 = __builtin_shufflevector(lo0, hv0, 0, 1, 2, 3, 4, 5, 6, 7), vf1 = __builtin_shufflevector(lo1, hv1, 0, 1, 2, 3, 4, 5, 6, 7);
            o[t4] = __builtin_amdgcn_mfma_f32_32x32x16_bf16(vf0, pa0, o[t4], 0, 0, 0);
            o[t4] = __builtin_amdgcn_mfma_f32_32x32x16_bf16(vf1, pa1, o[t4], 0, 0, 0);
        }
    }
    LBAR();
    auto tile = [&](const int j, auto DIAG) __attribute__((always_inline)) {
        constexpr bool diag = decltype(DIAG)::value;
        if (!diag) AT_DMA(j + 1);
        const ldsp sl = lds + (j & 1) * AT_SLOT;
        {
            f32x16 s[4];
            {
                f32x16 negm;
#pragma unroll
                for (int i = 0; i < 16; ++i) negm[i] = -mhat;
#pragma unroll
                for (int ks = 0; ks < 4; ++ks) {
                    bf16x8 kf[4];
#pragma unroll
                    for (int sb = 0; sb < 4; ++sb) kf[sb] = *(const LAS bf16x8*)(sl + kaddr[ks] + sb * 8192);
#pragma unroll
                    for (int sb = 0; sb < 4; ++sb) s[sb] = __builtin_amdgcn_mfma_f32_32x32x16_bf16(kf[sb], qf[ks], ks == 0 ? negm : s[sb], 0, 0, 0);
                }
            }
            if constexpr (diag) {
#pragma unroll
                for (int sb = 0; sb < 4; ++sb)
#pragma unroll
                    for (int i = 0; i < 16; ++i) { const int key = 128 * j + 32 * sb + crow(i, hi); if (key > qL) s[sb][i] = -1e30f; }
            }
            float ma = max3f(s[0][0], s[0][1], s[0][2]), mb = max3f(s[0][3], s[1][0], s[1][1]);
#pragma unroll
            for (int sb = 0; sb < 4; ++sb)
#pragma unroll
                for (int i = 0; i < 16; i += 4) { ma = max3f(ma, s[sb][i], s[sb][i + 1]); mb = max3f(mb, s[sb][i + 2], s[sb][i + 3]); }
            float rm = fmaxf(ma, mb);
            rm = fmaxf(rm, __shfl_xor(rm, 32));
            if (__any(rm > AT_THR)) {
                const float dl = fmaxf(rm, 0.f);
                mhat += dl;
#pragma unroll
                for (int sb = 0; sb < 4; ++sb)
#pragma unroll
                    for (int i = 0; i < 16; ++i) s[sb][i] -= dl;
                const float f = fexp2(-dl);
                lrun *= f;
#pragma unroll
                for (int t4 = 0; t4 < 4; ++t4)
#pragma unroll
                    for (int i = 0; i < 16; ++i) o[t4][i] *= f;
            }
            float ls0 = 0.f, ls1 = 0.f;
#pragma unroll
            for (int sb = 0; sb < 4; ++sb) {
#pragma unroll
                for (int i = 0; i < 16; i += 2) { s[sb][i] = fexp2(s[sb][i]); s[sb][i + 1] = fexp2(s[sb][i + 1]); ls0 += s[sb][i]; ls1 += s[sb][i + 1]; }
                u32x4 p0 = (u32x4){cvtpk_s(s[sb][0], s[sb][1]), cvtpk_s(s[sb][2], s[sb][3]), cvtpk_s(s[sb][4], s[sb][5]), cvtpk_s(s[sb][6], s[sb][7])};
                u32x4 p1 = (u32x4){cvtpk_s(s[sb][8], s[sb][9]), cvtpk_s(s[sb][10], s[sb][11]), cvtpk_s(s[sb][12], s[sb][13]), cvtpk_s(s[sb][14], s[sb][15])};
                const bf16x8 pa0 = __builtin_bit_cast(bf16x8, p0), pa1 = __builtin_bit_cast(bf16x8, p1);
                bf16x8 vf0[4], vf1[4];
#pragma unroll
                for (int t4 = 0; t4 < 4; ++t4) {
                    const s16x4 lo0 = vtr(sl + vaddr[t4] + (32 * sb) * 256);
                    const s16x4 hv0 = vtr(sl + vaddr[t4] + (32 * sb + 8) * 256);
                    const s16x4 lo1 = vtr(sl + vaddr[t4] + (32 * sb + 16) * 256);
                    const s16x4 hv1 = vtr(sl + vaddr[t4] + (32 * sb + 24) * 256);
                    vf0[t4] = __builtin_shufflevector(lo0, hv0, 0, 1, 2, 3, 4, 5, 6, 7);
                    vf1[t4] = __builtin_shufflevector(lo1, hv1, 0, 1, 2, 3, 4, 5, 6, 7);
                }
#pragma unroll
                for (int t4 = 0; t4 < 4; ++t4) o[t4] = __builtin_amdgcn_mfma_f32_32x32x16_bf16(vf0[t4], pa0, o[t4], 0, 0, 0);
#pragma unroll
                for (int t4 = 0; t4 < 4; ++t4) o[t4] = __builtin_amdgcn_mfma_f32_32x32x16_bf16(vf1[t4], pa1, o[t4], 0, 0, 0);
            }
            lrun += ls0 + ls1;
        }
        asm volatile("s_waitcnt vmcnt(0)" ::: "memory");
        LBAR();
    };
    for (int j = 1; j < qblk; ++j) tile(j, std::false_type{});
    tile(qblk, std::true_type{});
#undef AT_DMA
    lrun += __shfl_xor(lrun, 32);
    const float inv = 1.0f / lrun;
    if (comp == 1) {
#pragma unroll
        for (int t4 = 0; t4 < 4; ++t4)
#pragma unroll
            for (int i = 0; i < 16; ++i) *(LAS float*)(lds + AT_X + ((qsub * 64 + t4 * 16 + i) * 64 + lane) * 4) = o[t4][i] * inv;
    }
    LBAR();
    if (comp == 0) {
        float ss = 0.f;
#pragma unroll
        for (int t4 = 0; t4 < 4; ++t4)
#pragma unroll
            for (int i = 0; i < 16; ++i) { const float x2 = *(const LAS float*)(lds + AT_X + ((qsub * 64 + t4 * 16 + i) * 64 + lane) * 4);
                const float v = o[t4][i] * inv - lam * x2; o[t4][i] = v; ss += v * v; }
        ss += __shfl_xor(ss, 32);
        const float rstd = 0.8f / sqrtf(ss * (1.0f / 128.0f) + 1e-6f);
        bf16_t* op = OB + ((size_t)b * SEQ + (qL - 128)) * DM + h * 128;
#pragma unroll
        for (int t4 = 0; t4 < 4; ++t4)
#pragma unroll
            for (int g4 = 0; g4 < 4; ++g4) {
                const int dv = 32 * t4 + 8 * g4 + 4 * hi;
                const f32x4 gg = *(const f32x4*)(gB + dv);
                const u32x2 pk = (u32x2){pk2(o[t4][4 * g4] * rstd * gg[0], o[t4][4 * g4 + 1] * rstd * gg[1]), pk2(o[t4][4 * g4 + 2] * rstd * gg[2], o[t4][4 * g4 + 3] * rstd * gg[3])};
                *(u32x2*)(op + dv) = pk;
            }
    }
}

__device__ __forceinline__ f32x4 meta_dot(const bf16_t* ua, const bf16_t* wb) {
    f32x4 c0 = (f32x4){0.f, 0.f, 0.f, 0.f}, c1 = c0;
#pragma unroll 4
    for (int ks = 0; ks < 32; ks += 2) {
        const bf16x8 a0 = *(const bf16x8*)(ua + 32 * ks), b0 = *(const bf16x8*)(wb + 32 * ks);
        const bf16x8 a1 = *(const bf16x8*)(ua + 32 * ks + 32), b1 = *(const bf16x8*)(wb + 32 * ks + 32);
        c0 = __builtin_amdgcn_mfma_f32_16x16x32_bf16(a0, b0, c0, 0, 0, 0);
        c1 = __builtin_amdgcn_mfma_f32_16x16x32_bf16(a1, b1, c1, 0, 0, 0);
    }
    return c0 + c1;
}
__device__ __forceinline__ void meta_task(const bf16_t* U, const bf16_t* WIN, bf16_t* P, const float* lb, const float* rope, float* EVG, int task, int lane) {
    const int fr = lane & 15, fq = lane >> 4;
    const bf16_t* ua = U + (size_t)(MREAL + fr) * DM + 8 * fq;
    if (task < 64) {
        const int t = task >> 3, uu = task & 7, ch = 16 * uu + fr;
        const f32x4 cq = meta_dot(ua, WIN + (size_t)(256 * t + 16 * uu + fr) * DM + 8 * fq);
        const f32x4 cf = meta_dot(ua, WIN + (size_t)(256 * t + 128 + 16 * uu + fr) * DM + 8 * fq);
        const float lbv = lb[t * 128 + ch];
        float f[4], bc[4], run = 0.f;
#pragma unroll
        for (int i = 0; i < 4; ++i) { f[i] = lbv + (1.0f - lbv) * sigmoidf_(cf[i]); run += __logf(f[i]); bc[i] = run; }
        const float t16 = __shfl_up(run, 16), t32 = __shfl_up(run, 32), t48 = __shfl_up(run, 48);
        const float pre = (fq >= 1 ? t16 : 0.f) + (fq >= 2 ? t32 : 0.f) + (fq >= 3 ? t48 : 0.f);
        const float bl = __shfl(pre + run, 48 + fr);
        unsigned short oq[4], ok[4];
#pragma unroll
        for (int i = 0; i < 4; ++i) {
            const float d = fminf(fmaxf(pre + bc[i], -80.f), 80.f);
            const float e1 = fexp2(d * LOG2E), e2 = __builtin_amdgcn_rcpf(e1);
            oq[i] = (unsigned short)(pk2(cq[i] * e1, 0.f) & 0xffffu); ok[i] = (unsigned short)(pk2((1.0f - f[i]) * e2, 0.f) & 0xffffu);
        }
        const float elv = fexp2(bl * LOG2E);
        for (int b = 0; b < NB; ++b) {
#pragma unroll
            for (int i = 0; i < 4; ++i) { const size_t off = ((size_t)(b * 8 + t) * LP + PADN + 4 * fq + i) * 128 + ch; P[off] = oq[i]; P[PSTRIDE + off] = ok[i]; }
            if (fq == 0) { float* ev = EVG + ((size_t)((b * 8 + t) * 66 + 1)) * 384 + ch; ev[0] = 1.0f; ev[128] = elv; ev[256] = fexp2(fmaxf(bl, -100.f) * LOG2E); }
        }
        return;
    }
    const int n0 = 2048 + 16 * (task - 64), seg = 2 + ((n0 - 2048) >> 10), col = ((n0 - 2048) & 1023) + fr;
    f32x4 c = meta_dot(ua, WIN + (size_t)(n0 + fr) * DM + 8 * fq);
    if ((seg == 3 || seg == 4) && ((n0 & 63) == 0)) {
#pragma unroll
        for (int i = 0; i < 4; ++i) {
            const float p = __shfl_xor(c[i], 8);
            const float* rt = rope + (size_t)(4 * fq + i) * 16;
            const float cs = rt[fr & 7], sn = rt[8 + (fr & 7)];
            c[i] = (fr < 8) ? c[i] * cs - p * sn : c[i] * cs + p * sn;
        }
    }
    if (seg == 3) c = c * QSCALE;
    bf16_t* base = P + (size_t)seg * PSTRIDE + (col & 127);
#pragma unroll
    for (int i = 0; i < 4; ++i) { const unsigned short ob = (unsigned short)(pk2(c[i], 0.f) & 0xffffu);
        for (int b = 0; b < NB; ++b) base[((size_t)(b * 8 + (col >> 7)) * LP + PADN + 4 * fq + i) * 128] = ob; }
}

constexpr size_t WS_XBAR = 896 * 1024;
#define XB_TMO      128
#define XB_XCNT(j)  (256  + 64 * (j))
#define XB_XSUB(j)  (1280 + 64 * (j))
#define XB_XGEN(j)  (2304 + 64 * (j))
#define XB_TOP      3328
#define XB_TOPGEN   3392
#define XCD_BAR_WORDS 3456
#define XB_SPIN_CAP (1u << 18)

__device__ __forceinline__ unsigned xb_ld(unsigned* p)              { return __hip_atomic_load(p, __ATOMIC_RELAXED, __HIP_MEMORY_SCOPE_AGENT); }
__device__ __forceinline__ unsigned xb_add(unsigned* p, unsigned v) { return __hip_atomic_fetch_add(p, v, __ATOMIC_RELAXED, __HIP_MEMORY_SCOPE_AGENT); }
__device__ __forceinline__ unsigned xb_xcc_id() { return (unsigned)__builtin_amdgcn_s_getreg((3 << 11) | 20) & 0xFu; }
#define XB_SPIN(cond, bar) do { unsigned _sp = 0; while (cond) { __builtin_amdgcn_s_sleep(1); \
    if ((++_sp & 255u) == 0u) { if (xb_ld(&(bar)[XB_TMO])) break; if (_sp > XB_SPIN_CAP) { atomicAdd(&(bar)[XB_TMO], 1u); break; } } } } while (0)

struct XcdBarrier {
    unsigned* bar; unsigned x;
    volatile LAS unsigned* st;
};

__device__ __forceinline__ XcdBarrier xcd_barrier_post(unsigned* bar, volatile LAS unsigned* st) {
    XcdBarrier b; b.bar = bar; b.x = xb_xcc_id(); b.st = st;
    if (threadIdx.x == 0) (void)xb_add(&bar[XB_XCNT(b.x)], 1u);
    return b;
}
__device__ __forceinline__ void xcd_barrier_complete(unsigned* bar, unsigned x, unsigned& nloc, unsigned& nx) {
    const unsigned G = gridDim.x * gridDim.y * gridDim.z;
    unsigned sum, cnt, mine, sp = 0u;
    for (;;) {
        sum = 0u; cnt = 0u; mine = 0u;
#pragma unroll
        for (unsigned j = 0; j < 16; ++j) { const unsigned c = xb_ld(&bar[XB_XCNT(j)]); sum += c; cnt += (c > 0u) ? 1u : 0u; mine = (j == x) ? c : mine; }
        if (sum == G) break;
        __builtin_amdgcn_s_sleep(1);
        if ((++sp & 255u) == 0u) { if (xb_ld(&bar[XB_TMO])) break; if (sp > XB_SPIN_CAP) { atomicAdd(&bar[XB_TMO], 1u); break; } }
    }
    nloc = mine > 0u ? mine : 1u; nx = cnt > 0u ? cnt : 1u;
}

__device__ __forceinline__ void xcd_barrier(const XcdBarrier& b) {
    asm volatile("s_waitcnt vmcnt(0)" ::: "memory");
    __syncthreads();
    if (threadIdx.x == 0) {
        unsigned* bar = b.bar;
        __builtin_amdgcn_s_waitcnt(0);
        unsigned nloc = b.st[0], nx = b.st[1];
        if (nloc == 0u) { xcd_barrier_complete(bar, b.x, nloc, nx); b.st[0] = nloc; b.st[1] = nx; }
        const unsigned old = xb_add(&bar[XB_XSUB(b.x)], 1u);
        const unsigned gen = old / nloc;
        if (old + 1u == (gen + 1u) * nloc) {
            __builtin_amdgcn_fence(__ATOMIC_RELEASE, "agent");
            asm volatile("s_waitcnt vmcnt(0)" ::: "memory");
            const unsigned og = xb_add(&bar[XB_TOP], 1u);
            const unsigned tg = og / nx;
            if (og + 1u == (tg + 1u) * nx) xb_add(&bar[XB_TOPGEN], 1u);
            else XB_SPIN(xb_ld(&bar[XB_TOPGEN]) == tg, bar);
            __builtin_amdgcn_fence(__ATOMIC_ACQUIRE, "agent");
            xb_add(&bar[XB_XGEN(b.x)], 1u);
            asm volatile("s_waitcnt vmcnt(0)" ::: "memory");
        } else {
            XB_SPIN(xb_ld(&bar[XB_XGEN(b.x)]) == gen, bar);
            __builtin_amdgcn_fence(__ATOMIC_ACQUIRE, "agent");
            asm volatile("s_waitcnt vmcnt(0)" ::: "memory");
        }
    }
    __syncthreads();
}

#ifndef REPMASK
#define REPMASK 0
#endif
#define NREP(k) ((((REPMASK) >> (k)) & 1) + 1)
struct Args { const float* in[12]; float* out; unsigned char* ws; int ph_lo, ph_hi, flags, pad; };
constexpr int NPH = 7;

__global__ void __launch_bounds__(512, 2) mega_fwd(Args args) {
    extern __shared__ __attribute__((aligned(16))) unsigned char lds_raw[];
    ldsp lds = (ldsp)lds_raw;
    const int tid = threadIdx.x, lane = tid & 63, wave = __builtin_amdgcn_readfirstlane(tid >> 6);
    const int G = gridDim.x, bx = blockIdx.x;
    unsigned char* ws = args.ws;
    const float* x = args.in[0]; const float* meta = args.in[1]; const float* norm_g = args.in[2]; const float* w_in = args.in[3];
    const float* lb_logits = args.in[4]; const float* hg_g = args.in[5]; const float* da_lambda = args.in[6]; const float* da_g = args.in[7];
    const float* w_a = args.in[8]; const float* w_b = args.in[9]; const float* w_o = args.in[10]; const float* final_g = args.in[11];
    unsigned* ctl = (unsigned*)(ws + WS_CTL);
    float* lamp = (float*)(ws + WS_CTL + 1024);
    float* lbt = (float*)(ws + WS_LB);
    float* rope = (float*)(ws + WS_ROPE);
    float* rmsx = (float*)(ws + 512 * 1024);
    float* ginv = (float*)(ws + 768 * 1024);
    bf16_t* WIN = (bf16_t*)(ws + WS_WIN); bf16_t* WA = (bf16_t*)(ws + WS_WA); bf16_t* WB = (bf16_t*)(ws + WS_WB); bf16_t* WO = (bf16_t*)(ws + WS_WO);
    bf16_t* U = (bf16_t*)(ws + WS_U);
    float* EVG = (float*)(ws + WS_EV);
    float* SSQ = (float*)(ws + WS_SSQ);
    bf16_t* P = (bf16_t*)(ws + WS_P);
    bf16_t* OAB = (bf16_t*)args.out;
    const int lo = args.ph_lo, hi = args.ph_hi;
    cg::grid_group grid = cg::this_grid();
    volatile LAS unsigned* bst = (volatile LAS unsigned*)(lds + 131072 + 16);
    if (tid == 0) { bst[0] = 0u; bst[1] = 0u; }
    __syncthreads();
    const XcdBarrier xbar = xcd_barrier_post((unsigned*)(ws + WS_XBAR), bst);
    if (args.flags == 0x7fffffff) grid.sync();
#define IN(k) (lo <= (k) && (k) < hi)
#define SEAM(k) do { if (IN(k) && IN((k) + 1)) xcd_barrier(xbar); } while (0)

    if (IN(0)) for (int rep_ = 0; rep_ < NREP(0); ++rep_) {
        if (rep_) grid.sync();
        const int gw = bx * 8 + wave, NGW = G * 8;
        const int gt = bx * 512 + tid, NGT = G * 512;
        if (bx == 0 && tid < 8) ctl[16 * tid] = 0u;
        if (bx == 0 && tid == 0) {
            float s1 = 0.f, s2 = 0.f;
            for (int i = 0; i < 64; ++i) { s1 += da_lambda[i] * da_lambda[64 + i]; s2 += da_lambda[128 + i] * da_lambda[192 + i]; }
            *lamp = expf(s1) - expf(s2) + 0.2f;
        }
        for (int i = gt; i < 1024; i += NGT) { const float l0 = lb_logits[i], l1 = lb_logits[1024 + i]; lbt[i] = 1.0f / (1.0f + expf(l1 - l0)); ginv[i] = 1.0f / norm_g[i]; }
        for (int i = gt; i < 4112 * 8; i += NGT) { const int pos = i >> 3, j = i & 7;
            const float invf = powf(500000.0f, -(float)j * 0.125f); const float ang = (float)pos * invf;
            float sn, cs; sincos_d(ang, sn, cs); rope[pos * 16 + j] = cs; rope[pos * 16 + 8 + j] = sn; }
        LAS float* scr = (LAS float*)(lds + wave * 16384);
        constexpr int I_IN = 16 * 320, I_SQ = 16 * 32;
        for (int it = gw; it < I_IN + 3 * I_SQ; it += NGW) {
            if (it < I_IN) { const int kb = it / 320, nb = it % 320, n0 = nb * 32, sg = n0 >> 10;
                const int wi = n0 & 1023;
                const int drow = sg == 0 ? ((wi >> 7) * 256 + (wi & 127)) : sg == 1 ? ((wi >> 7) * 256 + 128 + (wi & 127))
                               : (int)((0x9875436210ULL >> (4 * sg)) & 0xFULL) * 1024 + wi;
                p0_transpose_item(w_in, 1024, 10240, WIN, drow, scr, kb * 64, n0, lane); }
            else { const int r = it - I_IN, m = r / I_SQ, q = r % I_SQ, kb = q / 32, nb = q % 32;
                const float* W = m == 0 ? w_a : (m == 1 ? w_b : w_o); bf16_t* WT = m == 0 ? WA : (m == 1 ? WB : WO);
                p0_transpose_item(W, 1024, 1024, WT, nb * 32, scr, kb * 64, nb * 32, lane); }
        }
        for (int m = gw; m < MU; m += NGW) {
            const float* xr = m < MREAL ? x + (size_t)m * DM : (m < MREAL + 16 ? meta + (size_t)(m - MREAL) * DM : nullptr);
            u_row(xr, norm_g, U + (size_t)m * DM, lane, m < MREAL ? rmsx + m : nullptr);
        }
        for (int i = gt; i < 6 * 64 * PADN * 16; i += NGT) { const int run = i / (PADN * 16), q = i % (PADN * 16), a6 = run >> 6, bh = run & 63;
            *(u32x4*)(P + (size_t)a6 * PSTRIDE + (size_t)bh * LP * 128 + (size_t)q * 8) = (u32x4){0u, 0u, 0u, 0u}; }
        __syncthreads();
    }
    SEAM(0);
    if (IN(1)) for (int rep_ = 0; rep_ < NREP(1); ++rep_) {
        if (rep_) grid.sync();
        { const int gw = bx * 8 + wave; if (gw < 320) meta_task(U, WIN, P, lbt, rope, EVG, gw, lane); }
        pg8::Gemm g{U, WIN, MREAL, 6144, 1024}; pg8::StaticOrder S; S.init(MREAL, 6144, G, bx);
        pg8::EpiProj E{P, lbt, rope, EVG};
        pg8::gemm_phase<pg8::EpiProj, pg8::StaticOrder, true, true>(lds, g, S, E);
        __syncthreads();
    }
    SEAM(1);
    if (IN(2)) {
        if (bx < 64 && !(args.flags & 1)) {
            hgrn_seq(lds, P, P + PSTRIDE, P + 2 * PSTRIDE, EVG, OAB, SSQ, hg_g, bx >> 3, bx & 7);
            float* RST = SSQ + (size_t)64 * 8 * SEQ;
            for (int sI = tid; sI < SEQ; sI += 512) { float tot = 0.f;
#pragma unroll
                for (int ww = 0; ww < 8; ++ww) tot += SSQ[((size_t)(bx * 8 + ww)) * SEQ + sI];
                RST[(size_t)bx * SEQ + sI] = __builtin_amdgcn_rsqf(tot * (1.0f / 128.0f) + 1e-6f); }
        }
        const float lam = *lamp;
        LAS unsigned* qslot = (LAS unsigned*)(lds + 131072);
        const int xq = bx & 7;
        if (!(args.flags & 2)) for (;;) {
            __syncthreads();
            if (tid == 0) *qslot = atomicAdd(ctl + 16 * xq, 1u);
            __syncthreads();
            const unsigned idx = *qslot;
            if (idx >= 256u) break;
            const int pass = (int)(idx >> 7), k = (int)(idx & 127u), bhl = k >> 4, qi = k & 15;
            const int qblk = (pass == 0 ? 32 : 16) - qi, bh = 8 * bhl + xq;
            attn_unit(lds, P + 3 * PSTRIDE, P + 4 * PSTRIDE, P + 5 * PSTRIDE, OAB + P3STRIDE, da_g, lam, bh >> 3, bh & 7, qblk);
        }
        __syncthreads();
    }
    SEAM(2);
    if (IN(3)) for (int rep_ = 0; rep_ < NREP(3); ++rep_) {
        if (rep_) grid.sync();
        pg8::Gemm g{U, WIN + (size_t)6144 * 1024, MREAL, 4096, 1024}; pg8::StaticOrder S; S.init(MREAL, 4096, G, bx);
        pg8::EpiGate E{P, OAB, SSQ + (size_t)64 * 8 * SEQ};
        pg8::gemm_phase<pg8::EpiGate, pg8::StaticOrder, true, true>(lds, g, S, E);
        __syncthreads();
    }
    SEAM(3);
    if (IN(4)) for (int rep_ = 0; rep_ < NREP(4); ++rep_) {
        if (rep_) grid.sync();
        bf16_t* Mx = P + 4 * P3STRIDE;
        { pg8::Gemm g{P, WA, MREAL, 1024, 1024}; pg8::StaticOrder S; S.init(MREAL, 1024, G, bx);
          pg8::EpiMix<0> E{Mx, P + 2 * P3STRIDE};
          pg8::gemm_phase<pg8::EpiMix<0>, pg8::StaticOrder, true, true>(lds, g, S, E); }
        __syncthreads();
        { pg8::Gemm g{P + P3STRIDE, WB, MREAL, 1024, 1024}; pg8::StaticOrder S; S.init(MREAL, 1024, G, bx);
          pg8::EpiMix<1> E{Mx, P + 3 * P3STRIDE};
          pg8::gemm_phase<pg8::EpiMix<1>, pg8::StaticOrder, true, true>(lds, g, S, E); }
        __syncthreads();
    }
    SEAM(4);
    if (IN(5)) for (int rep_ = 0; rep_ < NREP(5); ++rep_) {
        if (rep_) grid.sync();
        pg8::Gemm g{P + 4 * P3STRIDE, WO, MREAL, 1024, 1024}; pg8::StaticOrder S; S.init(MREAL, 1024, G, bx);
        pg8::EpiOut E{U, rmsx, ginv, P + 5 * P3STRIDE};
        pg8::gemm_phase<pg8::EpiOut, pg8::StaticOrder, true, true>(lds, g, S, E);
        __syncthreads();
    }
    SEAM(5);
    if (IN(6)) {
        const int gw = bx * 8 + wave, NGW = G * 8;
        const bf16_t* H16 = P + 5 * P3STRIDE;
        f32x4 g0[2], g1[2];
#pragma unroll
        for (int j = 0; j < 2; ++j) { g0[j] = *(const f32x4*)(final_g + j * 512 + lane * 8); g1[j] = *(const f32x4*)(final_g + j * 512 + lane * 8 + 4); }
        for (int m = gw; m < MREAL; m += NGW) {
            const bf16_t* hrow = H16 + (size_t)m * DM; float* orow = args.out + (size_t)m * DM;
            float v[2][8]; float s = 0.f;
#pragma unroll
            for (int j = 0; j < 2; ++j) { const u32x4 hv = *(const u32x4*)(hrow + j * 512 + lane * 8);
                v[j][0] = bflo(hv.x); v[j][1] = bfhi(hv.x); v[j][2] = bflo(hv.y); v[j][3] = bfhi(hv.y); v[j][4] = bflo(hv.z); v[j][5] = bfhi(hv.z); v[j][6] = bflo(hv.w); v[j][7] = bfhi(hv.w);
#pragma unroll
                for (int i = 0; i < 8; ++i) s += v[j][i] * v[j][i]; }
            const float rstd = 1.0f / sqrtf(wave_sum(s) * (1.0f / DM) + 1e-6f);
#pragma unroll
            for (int j = 0; j < 2; ++j) {
                *(f32x4*)(orow + j * 512 + lane * 8) = (f32x4){v[j][0] * rstd * g0[j][0], v[j][1] * rstd * g0[j][1], v[j][2] * rstd * g0[j][2], v[j][3] * rstd * g0[j][3]};
                *(f32x4*)(orow + j * 512 + lane * 8 + 4) = (f32x4){v[j][4] * rstd * g1[j][0], v[j][5] * rstd * g1[j][1], v[j][6] * rstd * g1[j][2], v[j][7] * rstd * g1[j][3]};
            }
        }
    }
#undef IN
#undef SEAM
}

#ifndef MK_LAUNCHES
#define MK_LAUNCHES 1
#endif

extern "C" void kernel_launch(void* const* d_in, const int* in_sizes, int n_in, void* d_out, int out_size, void* d_ws, size_t ws_size, hipStream_t stream) {
    static int grid = 0;
    if (grid == 0) {
        if (n_in != 12 || out_size != MREAL * DM || ws_size < WS_NEED) { fprintf(stderr, "kernel_launch: unexpected shapes (n_in %d out %d ws %zu need %zu)\n", n_in, out_size, ws_size, (size_t)WS_NEED); grid = -1; return; }
        int dev = 0, cus = 0, per_cu = 0;
        hipGetDevice(&dev); hipDeviceGetAttribute(&cus, hipDeviceAttributeMultiprocessorCount, dev);
        if (hipFuncSetAttribute((const void*)mega_fwd, hipFuncAttributeMaxDynamicSharedMemorySize, LDS_BYTES) != hipSuccess) { fprintf(stderr, "kernel_launch: hipFuncSetAttribute failed\n"); grid = -1; return; }
        hipOccupancyMaxActiveBlocksPerMultiprocessor(&per_cu, (const void*)mega_fwd, 512, LDS_BYTES);
        (void)hipGetLastError();
        if (per_cu < 1) per_cu = 1;
        grid = cus;
        fprintf(stderr, "kernel_launch: cus %d per_cu %d grid %d\n", cus, per_cu, grid);
    }
    if (grid < 0) return;
    Args a{};
    for (int i = 0; i < 12; ++i) a.in[i] = (const float*)d_in[i];
    a.out = (float*)d_out; a.ws = (unsigned char*)d_ws;
#if MK_LAUNCHES == 1
    void* kargs[] = {&a};
#ifndef MK_PROBE
#define MK_PROBE 0
#endif
#if MK_PROBE == 0
    a.ph_lo = 0; a.ph_hi = NPH;
    (void)hipMemsetAsync((char*)d_ws + WS_XBAR, 0, 16384, stream);
    hipError_t e = hipLaunchCooperativeKernel((const void*)mega_fwd, dim3(grid), dim3(512), kargs, LDS_BYTES, stream);
    if (e != hipSuccess) fprintf(stderr, "kernel_launch: cooperative launch failed: %s (grid %d)\n", hipGetErrorString(e), grid);
#else
    a.ph_lo = 0; a.ph_hi = MK_PROBE_PH + 1; a.flags = 0;
    (void)hipMemsetAsync((char*)d_ws + WS_XBAR, 0, 16384, stream);
    (void)hipLaunchCooperativeKernel((const void*)mega_fwd, dim3(grid), dim3(512), kargs, LDS_BYTES, stream);
    (void)hipMemsetAsync(d_ws, 0, 512, stream);
    (void)hipMemsetAsync((char*)d_ws + WS_XBAR, 0, 16384, stream);
    a.ph_lo = MK_PROBE_PH; a.ph_hi = MK_PROBE_PH + 1; a.flags = MK_PROBE_FLAGS;
    (void)hipLaunchCooperativeKernel((const void*)mega_fwd, dim3(grid), dim3(512), kargs, LDS_BYTES, stream);
    a.ph_lo = MK_PROBE_PH + 1; a.ph_hi = NPH; a.flags = 0;
    (void)hipMemsetAsync((char*)d_ws + WS_XBAR, 0, 16384, stream);
    (void)hipLaunchCooperativeKernel((const void*)mega_fwd, dim3(grid), dim3(512), kargs, LDS_BYTES, stream);
#endif
#else
    for (int p = 0; p < NPH; ++p) { a.ph_lo = p; a.ph_hi = p + 1; hipLaunchKernelGGL(mega_fwd, dim3(grid), dim3(512), LDS_BYTES, stream, a); }
#endif
}
```

```cpp
#include <hip/hip_runtime.h>
#include <hip/hip_cooperative_groups.h>
#include <cstdio>
#include <cstdint>
#include <type_traits>
namespace cg = cooperative_groups;
namespace pg8 {
#define PG8_LAS __attribute__((address_space(3)))
typedef unsigned short bf16_t;
typedef short bf16x8 __attribute__((ext_vector_type(8)));
typedef float f32x4 __attribute__((ext_vector_type(4)));
typedef unsigned u32x4 __attribute__((ext_vector_type(4)));
constexpr int BM = 256, BK = 64, HALF = 128, HTB = HALF * BK * 2  , STAGE_BYTES = 8 * HTB, NXCD = 8, WGM = 8;

__host__ __device__ __forceinline__ int lds_byte(int r, int c) { const int st = (r >> 4) * 2 + (c >> 5), rr = r & 15, cc = c & 31, ob = rr * 64 + cc * 2; return st * 1024 + (ob ^ (((ob >> 9) & 1) << 5)); }
__host__ __device__ __forceinline__ void stage_rc(int b, int& R, int& C) { const int st = b / 1024, sb = b % 1024, swz = sb ^ (((sb >> 9) & 1) << 5); R = (st >> 1) * 16 + swz / 64; C = (st & 1) * 32 + (swz % 64) / 2; }
__host__ __device__ __forceinline__ int perm32(int rho) { const int n = rho >> 4, i = rho & 15; return 8 * (i >> 2) + 4 * n + (i & 3); }

struct Unit { int pm, pn; };
struct Gemm { const bf16_t* A; const bf16_t* Bt; int M, N, K; };

struct StaticOrder {
    int nM, nN, nwg, G, c;
    __host__ __device__ void init(int M, int N, int G_, int c_) { nM = M / BM; nN = N / BM; nwg = nM * nN; G = G_; c = c_; }
    __host__ __device__ bool next(int i, Unit& u) const {
        const long L = (long)i * G + c; if (L >= nwg) return false;
        int wgid = (int)L; { const int q = nwg / NXCD, r = nwg % NXCD, xcd = wgid % NXCD, off = wgid / NXCD; wgid = (xcd < r ? xcd * (q + 1) : r * (q + 1) + (xcd - r) * q) + off; }
        const int nig = WGM * nN, gid = wgid / nig, fm = gid * WGM, gsz = (nM - fm) < WGM ? (nM - fm) : WGM;
        u.pm = fm + ((wgid % nig) % gsz); u.pn = (wgid % nig) / gsz; return true;
    }
    __device__ __forceinline__ void a_ready(const Unit&) const {}
    __device__ __forceinline__ void done(const Unit&) const {}
};

__device__ __forceinline__ unsigned cvt_pk_bf16(float lo, float hi) { unsigned r; asm volatile("v_cvt_pk_bf16_f32 %0, %1, %2" : "=v"(r) : "v"(lo), "v"(hi)); return r; }
typedef float f32x2 __attribute__((ext_vector_type(2)));
template <class Epi, class Sched, bool ALIGN_EPI = false, bool SP2 = false>
__device__ __forceinline__ void gemm_phase(PG8_LAS unsigned char* lds, const Gemm g, const Sched& S, const Epi& E) {
    const int tid = threadIdx.x, wid = __builtin_amdgcn_readfirstlane(tid >> 6), lane = tid & 63, wr = wid >> 2, wc = wid & 3, fr = lane & 15, fq = lane >> 4;
    const int K = g.K, nt = K / BK;
    unsigned voffA[2], voffB[2];
#pragma unroll
    for (int i = 0; i < 2; ++i) { int R, C; stage_rc(tid * 16 + i * 8192, R, C); const int Rb = Epi::PERM ? ((R & ~31) + perm32(R & 31)) : R;
        voffA[i] = (unsigned)(R * K + C) * 2u; voffB[i] = (unsigned)(Rb * K + C) * 2u; }
    const size_t kstep = (size_t)(BK * 2);
    const size_t hstep = (size_t)HALF * K * 2;
    const size_t tstep = 2 * hstep;
    const unsigned ldsw = (unsigned)wid * 1024u;
    const int aoff = lds_byte(wr * 64 + fr, fq * 8), boff = lds_byte(wc * 32 + fr, fq * 8);
#define PG8_SA(b, h) (((b) * 2 + (h)) * HTB)
#define PG8_SB(b, h) ((4 + (b) * 2 + (h)) * HTB)
#define PG8_STAGE(bufoff, gbase, voff) do { _Pragma("unroll") for (int _i = 0; _i < 2; ++_i) \
        __builtin_amdgcn_global_load_lds((const unsigned*)((const char*)(gbase) + (voff)[_i]), (PG8_LAS unsigned*)(lds + (bufoff) + ldsw + _i * 8192), 16, 0, 0); } while (0)
#define PG8_LDA(dst, b, h) do { _Pragma("unroll") for (int m = 0; m < 4; ++m) _Pragma("unroll") for (int k = 0; k < 2; ++k) dst[m][k] = *(const PG8_LAS bf16x8*)(lds + PG8_SA(b, h) + aoff + m * 2048 + k * 1024); } while (0)
#define PG8_LDB(dst, b, h) do { _Pragma("unroll") for (int n = 0; n < 2; ++n) _Pragma("unroll") for (int k = 0; k < 2; ++k) dst[n][k] = *(const PG8_LAS bf16x8*)(lds + PG8_SB(b, h) + boff + n * 2048 + k * 1024); } while (0)
#define PG8_MMA(ai, bj, At, Bt) do { __builtin_amdgcn_s_setprio(1); _Pragma("unroll") for (int m = 0; m < 4; ++m) _Pragma("unroll") for (int n = 0; n < 2; ++n) _Pragma("unroll") for (int k = 0; k < 2; ++k) \
        acc[ai][bj][m][n] = __builtin_amdgcn_mfma_f32_16x16x32_bf16(Bt[n][k], At[m][k], acc[ai][bj][m][n], 0, 0, 0); __builtin_amdgcn_s_setprio(0); } while (0)
#define PG8_WAIT_V(n) asm volatile("s_waitcnt vmcnt(" #n ")" ::: "memory")
#define PG8_WAIT_L(n) asm volatile("s_waitcnt lgkmcnt(" #n ")" ::: "memory")
#define PG8_BAR __builtin_amdgcn_s_barrier()
#define PG8_SCHED __builtin_amdgcn_sched_barrier(0)
    Unit cur, nxt; int ui = 0;
    if (!S.next(0, cur)) return;
    f32x4 acc[2][2][4][2];
#pragma unroll
    for (int a = 0; a < 2; ++a)
#pragma unroll
        for (int b = 0; b < 2; ++b)
#pragma unroll
            for (int m = 0; m < 4; ++m)
#pragma unroll
                for (int n = 0; n < 2; ++n) acc[a][b][m][n] = (f32x4){0.f, 0.f, 0.f, 0.f};
    bf16x8 At[4][2], B0[2][2], B1[2][2];
    const char* cA = (const char*)g.A + (size_t)cur.pm * tstep; const char* cB = (const char*)g.Bt + (size_t)cur.pn * tstep;
    S.a_ready(cur);
    if constexpr (SP2) {
        PG8_STAGE(PG8_SB(0, 0), cB, voffB); PG8_STAGE(PG8_SB(0, 1), cB + hstep, voffB); PG8_STAGE(PG8_SA(0, 0), cA, voffA); PG8_STAGE(PG8_SA(0, 1), cA + hstep, voffA);
        if (wr == 1) PG8_BAR;
        PG8_WAIT_V(2); PG8_BAR;
        PG8_STAGE(PG8_SB(1, 0), cB + kstep, voffB); PG8_STAGE(PG8_SA(1, 0), cA + kstep, voffA); PG8_STAGE(PG8_SB(1, 1), cB + hstep + kstep, voffB);
        PG8_WAIT_V(6); PG8_BAR;
    } else {
        PG8_STAGE(PG8_SB(0, 0), cB, voffB); PG8_STAGE(PG8_SA(0, 0), cA, voffA); PG8_STAGE(PG8_SB(0, 1), cB + hstep, voffB); PG8_STAGE(PG8_SA(0, 1), cA + hstep, voffA);
        if (wr == 1) PG8_BAR;
        PG8_WAIT_V(4); PG8_BAR;
        PG8_STAGE(PG8_SB(1, 0), cB + kstep, voffB); PG8_STAGE(PG8_SA(1, 0), cA + kstep, voffA); PG8_STAGE(PG8_SB(1, 1), cB + hstep + kstep, voffB);
        PG8_WAIT_V(6); PG8_BAR;
    }
    for (;;) {
        const bool has_next = S.next(ui + 1, nxt);
        const char* nA = has_next ? (const char*)g.A + (size_t)nxt.pm * tstep : cA; const char* nB = has_next ? (const char*)g.Bt + (size_t)nxt.pn * tstep : cB;
        for (int t = 0; t < nt; t += 2) {
            const bool last = (t == nt - 2);
            const char* a1 = cA + (size_t)(t + 1) * kstep;
            const char* a2 = last ? nA : cA + (size_t)(t + 2) * kstep; const char* b2 = last ? nB : cB + (size_t)(t + 2) * kstep;
            const char* a3 = a2 + kstep; const char* b3 = b2 + kstep;
            if (last && has_next) S.a_ready(nxt);
            if constexpr (SP2) {
            PG8_LDB(B0, 0, 0); PG8_LDB(B1, 0, 1); PG8_SCHED; PG8_LDA(At, 0, 0); PG8_STAGE(PG8_SA(1, 1), a1 + hstep, voffA);
            PG8_WAIT_V(8); PG8_WAIT_L(0); PG8_BAR; PG8_MMA(0, 0, At, B0); PG8_MMA(0, 1, At, B1); PG8_BAR; PG8_SCHED;
            PG8_LDA(At, 0, 1); PG8_STAGE(PG8_SB(0, 0), b2, voffB); PG8_STAGE(PG8_SB(0, 1), b2 + hstep, voffB); PG8_STAGE(PG8_SA(0, 0), a2, voffA);
            PG8_WAIT_V(8); PG8_WAIT_L(0); PG8_BAR; PG8_MMA(1, 0, At, B0); PG8_MMA(1, 1, At, B1); PG8_BAR; PG8_SCHED;
            PG8_LDB(B0, 1, 0); PG8_LDB(B1, 1, 1); PG8_SCHED; PG8_LDA(At, 1, 0); PG8_STAGE(PG8_SA(0, 1), a2 + hstep, voffA);
            PG8_WAIT_V(8); PG8_WAIT_L(0); PG8_BAR; PG8_MMA(0, 0, At, B0); PG8_MMA(0, 1, At, B1); PG8_BAR; PG8_SCHED;
            PG8_LDA(At, 1, 1); PG8_STAGE(PG8_SB(1, 0), b3, voffB); PG8_STAGE(PG8_SB(1, 1), b3 + hstep, voffB); PG8_STAGE(PG8_SA(1, 0), a3, voffA);
            PG8_WAIT_V(8); PG8_WAIT_L(0); PG8_BAR; PG8_MMA(1, 0, At, B0); PG8_MMA(1, 1, At, B1); PG8_BAR; PG8_SCHED;
            } else {
            PG8_LDB(B0, 0, 0); PG8_SCHED; PG8_LDA(At, 0, 0); PG8_STAGE(PG8_SA(1, 1), a1 + hstep, voffA);
            PG8_WAIT_L(8); PG8_BAR; PG8_WAIT_L(0); PG8_MMA(0, 0, At, B0); PG8_BAR; PG8_SCHED;
            PG8_LDB(B1, 0, 1); PG8_STAGE(PG8_SB(0, 0), b2, voffB);
            PG8_BAR; PG8_WAIT_L(0); PG8_MMA(0, 1, At, B1); PG8_BAR;
            PG8_LDA(At, 0, 1); PG8_STAGE(PG8_SA(0, 0), a2, voffA);
            PG8_BAR; PG8_WAIT_L(0); PG8_MMA(1, 0, At, B0); PG8_BAR; PG8_SCHED;
            PG8_STAGE(PG8_SB(0, 1), b2 + hstep, voffB);
            PG8_WAIT_V(6); PG8_BAR; PG8_MMA(1, 1, At, B1); PG8_BAR;
            PG8_LDB(B0, 1, 0); PG8_SCHED; PG8_LDA(At, 1, 0); PG8_STAGE(PG8_SA(0, 1), a2 + hstep, voffA);
            PG8_WAIT_L(8); PG8_BAR; PG8_WAIT_L(0); PG8_MMA(0, 0, At, B0); PG8_BAR; PG8_SCHED;
            PG8_LDB(B1, 1, 1); PG8_STAGE(PG8_SB(1, 0), b3, voffB);
            PG8_BAR; PG8_WAIT_L(0); PG8_MMA(0, 1, At, B1); PG8_BAR;
            PG8_LDA(At, 1, 1); PG8_STAGE(PG8_SA(1, 0), a3, voffA);
            PG8_BAR; PG8_WAIT_L(0); PG8_MMA(1, 0, At, B0); PG8_BAR; PG8_SCHED;
            PG8_STAGE(PG8_SB(1, 1), b3 + hstep, voffB);
            PG8_WAIT_V(6); PG8_BAR; PG8_MMA(1, 1, At, B1); PG8_BAR;
            }
        }
        if constexpr (ALIGN_EPI) { if (wr == 0) PG8_BAR; }
        if constexpr (!Epi::AFTER_DRAIN) { E(acc, cur, wr, wc, fr, fq); S.done(cur); }
        if (!has_next) break;
#pragma unroll
        for (int a = 0; a < 2; ++a)
#pragma unroll
            for (int b = 0; b < 2; ++b)
#pragma unroll
                for (int m = 0; m < 4; ++m)
#pragma unroll
                    for (int n = 0; n < 2; ++n) acc[a][b][m][n] = (f32x4){0.f, 0.f, 0.f, 0.f};
        cur = nxt; cA = nA; cB = nB; ++ui;
        if constexpr (ALIGN_EPI) { if (wr == 1) PG8_BAR; }
    }
    PG8_WAIT_V(0);
    if constexpr (!ALIGN_EPI) { if (wr == 0) PG8_BAR; }
    PG8_BAR;
    if constexpr (Epi::AFTER_DRAIN) { E.fused(acc, cur, wr, wc, fr, fq, lds, wid, lane); S.done(cur); }
#undef PG8_SA
#undef PG8_SB
#undef PG8_STAGE
#undef PG8_LDA
#undef PG8_LDB
#undef PG8_MMA
#undef PG8_WAIT_V
#undef PG8_WAIT_L
#undef PG8_BAR
#undef PG8_SCHED
}
}

#define LAS __attribute__((address_space(3)))
typedef unsigned short bf16_t;
typedef short bf16x8 __attribute__((ext_vector_type(8)));
typedef short s16x4 __attribute__((ext_vector_type(4)));
typedef float f32x4 __attribute__((ext_vector_type(4)));
typedef float f32x2v __attribute__((ext_vector_type(2)));
typedef float f32x16 __attribute__((ext_vector_type(16)));
typedef unsigned u32x4 __attribute__((ext_vector_type(4)));
typedef unsigned u32x2 __attribute__((ext_vector_type(2)));
typedef LAS unsigned char* ldsp;

constexpr int NB = 8, SEQ = 4096, DM = 1024, LP = 4224, PADN = 112;
constexpr int MREAL = NB * SEQ;
constexpr int MU = 33024;
constexpr size_t MiB = 1u << 20;
constexpr size_t WS_CTL = 0;
constexpr size_t WS_LB = 4096;
constexpr size_t WS_ROPE = 8192;
constexpr size_t WS_WIN = 1 * MiB;
constexpr size_t WS_WA = 21 * MiB, WS_WB = 23 * MiB, WS_WO = 25 * MiB;
constexpr size_t WS_U = 27 * MiB;
constexpr size_t WS_P = 92 * MiB;
constexpr size_t PSTRIDE = (size_t)NB * LP * DM;
constexpr size_t P3STRIDE = (size_t)MREAL * DM;
constexpr size_t WS_SSQ = 496 * MiB;
constexpr size_t WS_NEED = 506 * MiB;
constexpr float LOG2E = 1.4426950408889634f;
constexpr float QSCALE = 0.125f * LOG2E;
constexpr int LDS_BYTES = 131072 + 1024;

#define LBAR() do { asm volatile("s_waitcnt lgkmcnt(0)" ::: "memory"); __builtin_amdgcn_s_barrier(); asm volatile("" ::: "memory"); } while (0)
__device__ __forceinline__ float wave_sum(float v) {
#pragma unroll
    for (int o = 1; o < 64; o <<= 1) v += __shfl_xor(v, o);
    return v;
}
__device__ __forceinline__ unsigned pk2(float lo, float hi) { return pg8::cvt_pk_bf16(lo, hi); }
__device__ __forceinline__ float bflo(unsigned u) { return __builtin_bit_cast(float, u << 16); }
__device__ __forceinline__ float bfhi(unsigned u) { return __builtin_bit_cast(float, u & 0xffff0000u); }
__device__ __forceinline__ float h2f(unsigned short h) { return (float)__builtin_bit_cast(_Float16, h); }
__device__ __forceinline__ unsigned short f2h(float f) { return __builtin_bit_cast(unsigned short, (_Float16)f); }
__device__ __forceinline__ float fexp2(float x) { return __builtin_amdgcn_exp2f(x); }
__device__ __forceinline__ float mulx(float a, float b) { float r; asm("v_mul_f32_e32 %0, %1, %2" : "=v"(r) : "v"(a), "v"(b)); return r; }
__device__ __forceinline__ float sigmoidf_(float x) { return __builtin_amdgcn_rcpf(1.0f + fexp2(-x * LOG2E)); }

namespace pg8 {
template <int N> __device__ __forceinline__ float row_shr(float v) {
    return __builtin_bit_cast(float, __builtin_amdgcn_update_dpp(0, __builtin_bit_cast(int, v), 0x110 + N, 0xf, 0xf, true));
}
struct EpiProj {
    static constexpr bool PERM = true, AFTER_DRAIN = false;
    bf16_t* P; const float* lb; const float* rope; float* EVG;
    __device__ __forceinline__ void operator()(const f32x4 (&acc)[2][2][4][2], const Unit& u, int wr, int wc, int fr, int fq) const {
        const int lane = fr + 16 * fq;
        if (u.pn < 8) {
            const int head = u.pn, ch0 = 32 * wc + 8 * fq;
            const f32x4 lb0 = *(const f32x4*)(lb + head * 128 + ch0), lb1 = *(const f32x4*)(lb + head * 128 + ch0 + 4);
#pragma unroll
            for (int ai = 0; ai < 2; ++ai) {
                const int rp0 = u.pm * BM + ai * HALF + wr * 64;
                const int bb = rp0 >> 12, s0 = rp0 & 4095, cidx = 2 + (s0 >> 6);
                unsigned qpk[4][4], kpk[4][4]; float qev[4], kev[4];
                float emid[8], el[8], elm[8];
#pragma unroll
                for (int e = 0; e < 8; ++e) {
                    const float lbv = e < 4 ? lb0[e] : lb1[e - 4];
                    float f[4], bcs[4], carry = 0.f, ref = 0.f;
#pragma unroll
                    for (int m = 0; m < 4; ++m) {
                        f[m] = lbv + (1.0f - lbv) * sigmoidf_(acc[ai][1][m][e >> 2][e & 3]);
                        float v = __logf(f[m]);
                        v += row_shr<1>(v); v += row_shr<2>(v); v += row_shr<4>(v); v += row_shr<8>(v);
                        v += carry; bcs[m] = v;
                        carry = __shfl(v, (lane & 48) | 15);
                        if (m == 1) ref = carry;
                    }
                    const float bl = carry;
                    emid[e] = fexp2(ref * LOG2E); el[e] = fexp2(bl * LOG2E); elm[e] = fexp2(fmaxf(bl - ref, -100.f) * LOG2E);
#pragma unroll
                    for (int m = 0; m < 4; ++m) {
                        const float d = fminf(fmaxf(bcs[m] - ref, -80.f), 80.f);
                        const float e1 = fexp2(d * LOG2E), e2 = __builtin_amdgcn_rcpf(e1);
                        const float qe = acc[ai][0][m][e >> 2][e & 3] * e1, ke = (1.0f - f[m]) * e2;
                        if (e & 1) { qpk[m][e >> 1] = cvt_pk_bf16(qev[m], qe); kpk[m][e >> 1] = cvt_pk_bf16(kev[m], ke); }
                        else { qev[m] = qe; kev[m] = ke; }
                    }
                }
#pragma unroll
                for (int m = 0; m < 4; ++m) {
                    const size_t off = ((size_t)(bb * 8 + head) * LP + 128 + s0 + m * 16 + fr) * 128 + ch0;
                    *(u32x4*)(P + off) = (u32x4){qpk[m][0], qpk[m][1], qpk[m][2], qpk[m][3]};
                    *(u32x4*)(P + PSTRIDE + off) = (u32x4){kpk[m][0], kpk[m][1], kpk[m][2], kpk[m][3]};
                }
                if (fr == 15) {
                    float* ev = EVG + ((size_t)((bb * 8 + head) * 66 + cidx)) * 384 + ch0;
                    *(f32x4*)(ev) = (f32x4){emid[0], emid[1], emid[2], emid[3]}; *(f32x4*)(ev + 4) = (f32x4){emid[4], emid[5], emid[6], emid[7]};
                    *(f32x4*)(ev + 128) = (f32x4){el[0], el[1], el[2], el[3]}; *(f32x4*)(ev + 132) = (f32x4){el[4], el[5], el[6], el[7]};
                    *(f32x4*)(ev + 256) = (f32x4){elm[0], elm[1], elm[2], elm[3]}; *(f32x4*)(ev + 260) = (f32x4){elm[4], elm[5], elm[6], elm[7]};
                }
            }
            return;
        }
        const int seg = 2 + ((u.pn - 8) >> 2), cseg = ((u.pn - 8) & 3) * BM;
        bf16_t* base = P + (size_t)seg * PSTRIDE;
        const bool ropewave = ((seg == 3) || (seg == 4)) && ((wc & 1) == 0);
#pragma unroll
        for (int ai = 0; ai < 2; ++ai)
#pragma unroll
            for (int m = 0; m < 4; ++m) {
                const int rp = u.pm * BM + ai * HALF + wr * 64 + m * 16 + fr;
                const int bb = rp >> 12, s = rp & 4095;
                const int pos = 16 + s;
#pragma unroll
                for (int bj = 0; bj < 2; ++bj) {
                    const int c0 = cseg + bj * HALF + wc * 32 + 8 * fq;
                    float x[8];
#pragma unroll
                    for (int i = 0; i < 4; ++i) { x[i] = acc[ai][bj][m][0][i]; x[4 + i] = acc[ai][bj][m][1][i]; }
                    if (ropewave) {
                        float p[8];
#pragma unroll
                        for (int i = 0; i < 8; ++i) p[i] = __shfl_xor(x[i], 16);
                        if (fq < 2) {
                            const float* rt = rope + (size_t)pos * 16;
                            const f32x4 c0v = *(const f32x4*)(rt), c1v = *(const f32x4*)(rt + 4), s0v = *(const f32x4*)(rt + 8), s1v = *(const f32x4*)(rt + 12);
                            const float sg = fq == 0 ? -1.0f : 1.0f;
#pragma unroll
                            for (int i = 0; i < 8; ++i) { const float cs = i < 4 ? c0v[i] : c1v[i - 4], sn = i < 4 ? s0v[i] : s1v[i - 4];
                                x[i] = x[i] * cs + sg * p[i] * sn; }
                        }
                    }
                    if (seg == 3) {
#pragma unroll
                        for (int i = 0; i < 8; ++i) x[i] *= QSCALE;
                    }
                    u32x4 w; w.x = cvt_pk_bf16(x[0], x[1]); w.y = cvt_pk_bf16(x[2], x[3]); w.z = cvt_pk_bf16(x[4], x[5]); w.w = cvt_pk_bf16(x[6], x[7]);
                    *(u32x4*)(base + ((size_t)(bb * 8 + (c0 >> 7)) * LP + 128 + s) * 128 + (c0 & 127)) = w;
                }
            }
    }
};
struct EpiGate {
    static constexpr bool PERM = true, AFTER_DRAIN = false;
    bf16_t* T; const bf16_t* OAB; const float* RST;
    __device__ __forceinline__ void operator()(const f32x4 (&acc)[2][2][4][2], const Unit& u, int wr, int wc, int fr, int fq) const {
        const int colt = u.pn * BM, seg = colt >> 10, cseg = colt & 1023;
        bf16_t* base = T + (size_t)seg * P3STRIDE;
        const bf16_t* ob = OAB + (size_t)(seg & 1) * P3STRIDE;
#pragma unroll
        for (int ai = 0; ai < 2; ++ai) {
            u32x4 ov[4][2]; float rn[4][2];
            if (seg < 2) {
#pragma unroll
                for (int m = 0; m < 4; ++m)
#pragma unroll
                    for (int bj = 0; bj < 2; ++bj) {
                        const int rp = u.pm * BM + ai * HALF + wr * 64 + m * 16 + fr, c0 = cseg + bj * HALF + wc * 32 + 8 * fq;
                        ov[m][bj] = *(const u32x4*)(ob + (size_t)rp * DM + c0);
                        rn[m][bj] = seg == 0 ? RST[(size_t)((rp >> 12) * 8 + (c0 >> 7)) * SEQ + (rp & 4095)] : 1.0f;
                    }
            }
#pragma unroll
            for (int m = 0; m < 4; ++m) {
                const int rp = u.pm * BM + ai * HALF + wr * 64 + m * 16 + fr;
#pragma unroll
                for (int bj = 0; bj < 2; ++bj) {
                    const int c0 = cseg + bj * HALF + wc * 32 + 8 * fq;
                    const size_t off = (size_t)rp * DM + c0;
                    float x[8];
#pragma unroll
                    for (int i = 0; i < 4; ++i) { x[i] = acc[ai][bj][m][0][i]; x[4 + i] = acc[ai][bj][m][1][i]; }
                    if (seg < 2) {
                        const u32x4 o = ov[m][bj];
                        const float ovv[8] = {bflo(o.x), bfhi(o.x), bflo(o.y), bfhi(o.y), bflo(o.z), bfhi(o.z), bflo(o.w), bfhi(o.w)};
#pragma unroll
                        for (int i = 0; i < 8; ++i) x[i] = mulx(mulx(x[i], sigmoidf_(x[i])), mulx(ovv[i], rn[m][bj]));
                    } else {
#pragma unroll
                        for (int i = 0; i < 8; ++i) x[i] = sigmoidf_(x[i]);
                    }
                    u32x4 w; w.x = cvt_pk_bf16(x[0], x[1]); w.y = cvt_pk_bf16(x[2], x[3]); w.z = cvt_pk_bf16(x[4], x[5]); w.w = cvt_pk_bf16(x[6], x[7]);
                    *(u32x4*)(base + off) = w;
                }
            }
        }
    }
};
template <int STEP> struct EpiMix {
    static constexpr bool PERM = true, AFTER_DRAIN = false;
    bf16_t* M; const bf16_t* SG;
    __device__ __forceinline__ void operator()(const f32x4 (&acc)[2][2][4][2], const Unit& u, int wr, int wc, int fr, int fq) const {
        const int colt = u.pn * BM;
#pragma unroll
        for (int ai = 0; ai < 2; ++ai) {
            u32x4 gq[4][2], pq[4][2];
#pragma unroll
            for (int m = 0; m < 4; ++m)
#pragma unroll
                for (int bj = 0; bj < 2; ++bj) {
                    const size_t off = (size_t)(u.pm * BM + ai * HALF + wr * 64 + m * 16 + fr) * DM + colt + bj * HALF + wc * 32 + 8 * fq;
                    gq[m][bj] = *(const u32x4*)(SG + off);
                    if (STEP == 1) pq[m][bj] = *(const u32x4*)(M + off);
                }
#pragma unroll
            for (int m = 0; m < 4; ++m)
#pragma unroll
                for (int bj = 0; bj < 2; ++bj) {
                    const size_t off = (size_t)(u.pm * BM + ai * HALF + wr * 64 + m * 16 + fr) * DM + colt + bj * HALF + wc * 32 + 8 * fq;
                    float x[8];
#pragma unroll
                    for (int i = 0; i < 4; ++i) { x[i] = acc[ai][bj][m][0][i]; x[4 + i] = acc[ai][bj][m][1][i]; }
                    const u32x4 g = gq[m][bj];
                    const float gv[8] = {bflo(g.x), bfhi(g.x), bflo(g.y), bfhi(g.y), bflo(g.z), bfhi(g.z), bflo(g.w), bfhi(g.w)};
#pragma unroll
                    for (int i = 0; i < 8; ++i) x[i] = mulx(x[i], gv[i]);
                    if (STEP == 1) {
                        const u32x4 p = pq[m][bj];
                        const float pv[8] = {bflo(p.x), bfhi(p.x), bflo(p.y), bfhi(p.y), bflo(p.z), bfhi(p.z), bflo(p.w), bfhi(p.w)};
#pragma unroll
                        for (int i = 0; i < 8; ++i) x[i] += pv[i];
                    }
                    u32x4 w; w.x = cvt_pk_bf16(x[0], x[1]); w.y = cvt_pk_bf16(x[2], x[3]); w.z = cvt_pk_bf16(x[4], x[5]); w.w = cvt_pk_bf16(x[6], x[7]);
                    *(u32x4*)(M + off) = w;
                }
        }
    }
};
struct EpiOut {
    static constexpr bool PERM = true, AFTER_DRAIN = false;
    const bf16_t* Ub; const float* rmsx; const float* ginv; bf16_t* H;
    __device__ __forceinline__ void operator()(const f32x4 (&acc)[2][2][4][2], const Unit& u, int wr, int wc, int fr, int fq) const {
        f32x4 gi[2][2];
#pragma unroll
        for (int bj = 0; bj < 2; ++bj) { const int c0 = u.pn * BM + bj * HALF + wc * 32 + 8 * fq; gi[bj][0] = *(const f32x4*)(ginv + c0); gi[bj][1] = *(const f32x4*)(ginv + c0 + 4); }
#pragma unroll
        for (int ai = 0; ai < 2; ++ai) {
            u32x4 uq[4][2]; float rm[4];
#pragma unroll
            for (int m = 0; m < 4; ++m) {
                const int rp = u.pm * BM + ai * HALF + wr * 64 + m * 16 + fr;
                rm[m] = rmsx[rp];
#pragma unroll
                for (int bj = 0; bj < 2; ++bj) uq[m][bj] = *(const u32x4*)(Ub + (size_t)rp * DM + u.pn * BM + bj * HALF + wc * 32 + 8 * fq);
            }
#pragma unroll
            for (int m = 0; m < 4; ++m) {
                const int rp = u.pm * BM + ai * HALF + wr * 64 + m * 16 + fr;
#pragma unroll
                for (int bj = 0; bj < 2; ++bj) {
                    const size_t off = (size_t)rp * DM + u.pn * BM + bj * HALF + wc * 32 + 8 * fq;
                    const u32x4 uv = uq[m][bj];
                    const float uu[8] = {bflo(uv.x), bfhi(uv.x), bflo(uv.y), bfhi(uv.y), bflo(uv.z), bfhi(uv.z), bflo(uv.w), bfhi(uv.w)};
                    f32x4 x0, x1;
#pragma unroll
                    for (int i = 0; i < 4; ++i) { x0[i] = mulx(mulx(uu[i], gi[bj][0][i]), rm[m]) + acc[ai][bj][m][0][i]; x1[i] = mulx(mulx(uu[4 + i], gi[bj][1][i]), rm[m]) + acc[ai][bj][m][1][i]; }
                    u32x4 w; w.x = cvt_pk_bf16(x0[0], x0[1]); w.y = cvt_pk_bf16(x0[2], x0[3]); w.z = cvt_pk_bf16(x1[0], x1[1]); w.w = cvt_pk_bf16(x1[2], x1[3]);
                    *(u32x4*)(H + off) = w;
                }
            }
        }
    }
};
}

__device__ __forceinline__ void p0_transpose_item(const float* W, int K, int N, bf16_t* WT, int dst_row0, LAS float* scr, int k0, int n0, int lane) {
#pragma unroll
    for (int i = 0; i < 8; ++i) { const int kk = 8 * i + (lane >> 3), c4 = (lane & 7) * 4;
        const f32x4 v = *(const f32x4*)(W + (size_t)(k0 + kk) * N + n0 + c4);
        scr[kk * 33 + c4] = v.x; scr[kk * 33 + c4 + 1] = v.y; scr[kk * 33 + c4 + 2] = v.z; scr[kk * 33 + c4 + 3] = v.w; }
    asm volatile("s_waitcnt lgkmcnt(0)" ::: "memory");
    const int c = lane & 7;
#pragma unroll
    for (int j = 0; j < 4; ++j) { const int n = (lane >> 3) + 8 * j; const LAS float* s = scr + (8 * c) * 33 + n;
        u32x4 o; o.x = pk2(s[0 * 33], s[1 * 33]); o.y = pk2(s[2 * 33], s[3 * 33]); o.z = pk2(s[4 * 33], s[5 * 33]); o.w = pk2(s[6 * 33], s[7 * 33]);
        *(u32x4*)(WT + (size_t)(dst_row0 + n) * K + k0 + 8 * c) = o; }
    asm volatile("s_waitcnt lgkmcnt(0)" ::: "memory");
}
__device__ __forceinline__ void u_row(const float* xrow, const float* g, bf16_t* orow, int lane, float* rinv) {
    u32x2* o8 = (u32x2*)orow + lane;
    if (!xrow) {
#pragma unroll
        for (int j = 0; j < 4; ++j) o8[64 * j] = (u32x2){0u, 0u};
        return;
    }
    const f32x4* xr = (const f32x4*)xrow + lane; const f32x4* gr = (const f32x4*)g + lane;
    f32x4 v[4]; float s = 0.f;
#pragma unroll
    for (int j = 0; j < 4; ++j) { v[j] = xr[64 * j]; s += (v[j].x * v[j].x + v[j].y * v[j].y) + (v[j].z * v[j].z + v[j].w * v[j].w); }
    const float rms = sqrtf(wave_sum(s) * (1.0f / DM) + 1e-6f), rstd = 1.0f / rms;
    if (rinv && lane == 0) *rinv = rms;
#pragma unroll
    for (int j = 0; j < 4; ++j) { const f32x4 gv = gr[64 * j];
        o8[64 * j] = (u32x2){pk2(v[j].x * rstd * gv.x, v[j].y * rstd * gv.y), pk2(v[j].z * rstd * gv.z, v[j].w * rstd * gv.w)}; }
}
__device__ __forceinline__ void sincos_d(float af, float& sn, float& cs) {
    const double a = (double)af;
    const double k = __builtin_rint(a * 0.15915494309189535);
    const double r = a - k * 6.283185307179586;
    const double r2 = r * r;
    double s = 0.0, c = 0.0;
    double ts = 1.0, tc = 1.0;
#pragma unroll
    for (int n = 0; n < 16; ++n) {
        s += ts; c += tc;
        ts = -ts * r2 / (double)((2 * n + 2) * (2 * n + 3));
        tc = -tc * r2 / (double)((2 * n + 1) * (2 * n + 2));
    }
    sn = (float)(s * r); cs = (float)c;
}

constexpr size_t WS_EV = 489 * MiB;
__device__ __forceinline__ void hgrn_prep_unit(ldsp lds, bf16_t* HQ, bf16_t* LF, float* EVG, int b, int c, int h, int par) {
    const int tid = threadIdx.x, lane = tid & 63, w = __builtin_amdgcn_readfirstlane(tid >> 6);
    const size_t go0 = ((size_t)b * LP + 64 * c + 8 * w) * DM + h * 128 + 2 * lane;
    unsigned qv[8], lv[8];
#pragma unroll
    for (int i = 0; i < 8; ++i) { qv[i] = *(const unsigned*)(HQ + go0 + (size_t)i * DM); lv[i] = *(const unsigned*)(LF + go0 + (size_t)i * DM); }
    float b0[8], b1[8], r0 = 0.f, r1 = 0.f;
#pragma unroll
    for (int i = 0; i < 8; ++i) { r0 += h2f((unsigned short)(lv[i] & 0xffffu)); r1 += h2f((unsigned short)(lv[i] >> 16)); b0[i] = r0; b1[i] = r1; }
    ldsp wt = lds + par * 4096;
    *(LAS f32x2v*)(wt + (w * 128 + 2 * lane) * 4) = (f32x2v){r0, r1};
    LBAR();
    float pre0 = 0.f, pre1 = 0.f, ref0 = 0.f, ref1 = 0.f, bl0 = 0.f, bl1 = 0.f;
#pragma unroll
    for (int ww = 0; ww < 8; ++ww) { const f32x2v t = *(const LAS f32x2v*)(wt + (ww * 128 + 2 * lane) * 4);
        if (ww < w) { pre0 += t.x; pre1 += t.y; } if (ww < 4) { ref0 += t.x; ref1 += t.y; } bl0 += t.x; bl1 += t.y; }
    if (w == 0) {
        float* ev = EVG + ((size_t)((b * 8 + h) * 66 + c)) * 384 + 2 * lane;
        *(f32x2v*)(ev) = (f32x2v){fexp2(ref0 * LOG2E), fexp2(ref1 * LOG2E)};
        *(f32x2v*)(ev + 128) = (f32x2v){fexp2(bl0 * LOG2E), fexp2(bl1 * LOG2E)};
        *(f32x2v*)(ev + 256) = (f32x2v){fexp2(fmaxf(bl0 - ref0, -100.f) * LOG2E), fexp2(fmaxf(bl1 - ref1, -100.f) * LOG2E)};
    }
#pragma unroll
    for (int i = 0; i < 8; ++i) {
        const float d0 = fminf(fmaxf(pre0 + b0[i] - ref0, -80.f), 80.f), d1 = fminf(fmaxf(pre1 + b1[i] - ref1, -80.f), 80.f);
        const float e10 = fexp2(d0 * LOG2E), e11 = fexp2(d1 * LOG2E);
        const float e20 = __builtin_amdgcn_rcpf(e10), e21 = __builtin_amdgcn_rcpf(e11);
        const float k0 = 1.0f - fexp2(h2f((unsigned short)(lv[i] & 0xffffu)) * LOG2E), k1 = 1.0f - fexp2(h2f((unsigned short)(lv[i] >> 16)) * LOG2E);
        *(unsigned*)(HQ + go0 + (size_t)i * DM) = pk2(bflo(qv[i]) * e10, bfhi(qv[i]) * e11);
        *(unsigned*)(LF + go0 + (size_t)i * DM) = pk2(k0 * e20, k1 * e21);
    }
}

constexpr int HG_STR = 272;
constexpr int HG_QE = 0;
constexpr int HG_KE = HG_QE + 64 * HG_STR;
constexpr int HG_V = HG_KE + 64 * HG_STR;
constexpr int HG_A1 = HG_V + 64 * HG_STR, HG_TSTR = 144;
constexpr int HG_EV = HG_A1 + 64 * HG_TSTR;
constexpr int HG_SS = HG_EV + 3 * 128 * 4;
constexpr int HG_END = HG_SS + 8 * 64 * 4;
static_assert(HG_END <= 131072, "HGRN LDS");
typedef short v4i16_t __attribute__((ext_vector_type(4)));
__device__ __forceinline__ s16x4 vtr(ldsp p) { return __builtin_bit_cast(s16x4, __builtin_amdgcn_ds_read_tr16_b64_v4i16((LAS v4i16_t*)p)); }

__device__ __forceinline__ void hgrn_seq(ldsp lds, const bf16_t* HQ, const bf16_t* LF, const bf16_t* HI, const float* EVG, bf16_t* OA, float* SSQ, const float* gA, int b, int h) {
    const int tid = threadIdx.x, lane = tid & 63, w = __builtin_amdgcn_readfirstlane(tid >> 6), fr = lane & 15, fq = lane >> 4;
    const size_t rowb = (size_t)(b * 8 + h) * LP;
    f32x4 S[8];
#pragma unroll
    for (int i = 0; i < 8; ++i) S[i] = (f32x4){0.f, 0.f, 0.f, 0.f};
    const int srow = tid >> 3, sch = (tid & 7) * 2;
    const size_t gcol = (size_t)sch * 8;
    u32x4 rq0, rq1, rk0, rk1, rv0, rv1; f32x4 rev = (f32x4){0.f, 0.f, 0.f, 0.f};
#define HG_LOAD(c) do { const size_t go = (rowb + 64 * (c) + srow) * 128 + gcol; \
        rq0 = *(const u32x4*)(HQ + go); rq1 = *(const u32x4*)(HQ + go + 8); rk0 = *(const u32x4*)(LF + go); rk1 = *(const u32x4*)(LF + go + 8); \
        rv0 = *(const u32x4*)(HI + go); rv1 = *(const u32x4*)(HI + go + 8); \
        if (tid < 96) rev = *(const f32x4*)(EVG + ((size_t)((b * 8 + h) * 66 + (c))) * 384 + tid * 4); } while (0)
    HG_LOAD(1);
    const float gv = gA[16 * w + fr];
    const int trq = fr >> 2, trp = fr & 3;
    for (int c = 1; c <= 65; ++c) {
        LBAR();
        *(LAS u32x4*)(lds + HG_QE + srow * HG_STR + sch * 16) = rq0; *(LAS u32x4*)(lds + HG_QE + srow * HG_STR + sch * 16 + 16) = rq1;
        *(LAS u32x4*)(lds + HG_KE + srow * HG_STR + sch * 16) = rk0; *(LAS u32x4*)(lds + HG_KE + srow * HG_STR + sch * 16 + 16) = rk1;
        *(LAS u32x4*)(lds + HG_V + srow * HG_STR + sch * 16) = rv0; *(LAS u32x4*)(lds + HG_V + srow * HG_STR + sch * 16 + 16) = rv1;
        if (tid < 96) *(LAS f32x4*)(lds + HG_EV + tid * 16) = rev;
        if (c < 65) HG_LOAD(c + 1);
        LBAR();
        {
            const int ti = w >> 1;
#pragma unroll
            for (int e = 0; e < 2; ++e) {
                const int si = 2 * (w & 1) + e;
                f32x4 a = (f32x4){0.f, 0.f, 0.f, 0.f};
                if (si <= ti) {
#pragma unroll
                    for (int ks = 0; ks < 4; ++ks) {
                        const bf16x8 qa = *(const LAS bf16x8*)(lds + HG_QE + (16 * ti + fr) * HG_STR + (32 * ks + 8 * fq) * 2);
                        const bf16x8 kb = *(const LAS bf16x8*)(lds + HG_KE + (16 * si + fr) * HG_STR + (32 * ks + 8 * fq) * 2);
                        a = __builtin_amdgcn_mfma_f32_16x16x32_bf16(qa, kb, a, 0, 0, 0);
                    }
                }
                const int s = 16 * si + fr;
#pragma unroll
                for (int i = 0; i < 4; ++i) { const int t = 16 * ti + 4 * fq + i; const float val = (s <= t) ? a[i] : 0.f;
                    *(LAS unsigned short*)(lds + HG_A1 + t * HG_TSTR + 2 * s) = (unsigned short)(pk2(val, 0.f) & 0xffffu); }
            }
        }
        bf16x8 vf[2];
#pragma unroll
        for (int ks = 0; ks < 2; ++ks) {
            const s16x4 lo = vtr(lds + HG_V + (32 * ks + 8 * fq + trq) * HG_STR + (16 * w + 4 * trp) * 2);
            const s16x4 hi = vtr(lds + HG_V + (32 * ks + 8 * fq + 4 + trq) * HG_STR + (16 * w + 4 * trp) * 2);
            vf[ks] = __builtin_shufflevector(lo, hi, 0, 1, 2, 3, 4, 5, 6, 7);
        }
        bf16x8 sp[4];
#pragma unroll
        for (int a = 0; a < 4; ++a) {
            const f32x4 e0 = *(const LAS f32x4*)(lds + HG_EV + (32 * a + 4 * fq) * 4), e1 = *(const LAS f32x4*)(lds + HG_EV + (32 * a + 16 + 4 * fq) * 4);
            const f32x4 x0 = S[2 * a] * e0, x1 = S[2 * a + 1] * e1;
            const u32x4 pk = (u32x4){pk2(x0[0], x0[1]), pk2(x0[2], x0[3]), pk2(x1[0], x1[1]), pk2(x1[2], x1[3])};
            sp[a] = __builtin_bit_cast(bf16x8, pk);
        }
#pragma unroll
        for (int dt = 0; dt < 8; ++dt) {
            f32x4 acc = (f32x4){0.f, 0.f, 0.f, 0.f};
#pragma unroll
            for (int ks = 0; ks < 2; ++ks) {
                const s16x4 lo = vtr(lds + HG_KE + (32 * ks + 8 * fq + trq) * HG_STR + (16 * dt + 4 * trp) * 2);
                const s16x4 hi = vtr(lds + HG_KE + (32 * ks + 8 * fq + 4 + trq) * HG_STR + (16 * dt + 4 * trp) * 2);
                const bf16x8 kf = __builtin_shufflevector(lo, hi, 0, 1, 2, 3, 4, 5, 6, 7);
                acc = __builtin_amdgcn_mfma_f32_16x16x32_bf16(kf, vf[ks], acc, 0, 0, 0);
            }
            const f32x4 el = *(const LAS f32x4*)(lds + HG_EV + (128 + 16 * dt + 4 * fq) * 4), elm = *(const LAS f32x4*)(lds + HG_EV + (256 + 16 * dt + 4 * fq) * 4);
            S[dt] = S[dt] * el + acc * elm;
        }
        LBAR();
        f32x4 o[4];
#pragma unroll
        for (int tt = 0; tt < 4; ++tt) {
            f32x4 acc = (f32x4){0.f, 0.f, 0.f, 0.f};
#pragma unroll
            for (int ks = 0; ks < 2; ++ks) {
                const bf16x8 af = *(const LAS bf16x8*)(lds + HG_A1 + (16 * tt + fr) * HG_TSTR + (32 * ks + 8 * fq) * 2);
                acc = __builtin_amdgcn_mfma_f32_16x16x32_bf16(af, vf[ks], acc, 0, 0, 0);
            }
#pragma unroll
            for (int a = 0; a < 4; ++a) {
                const s16x4 lo = *(const LAS s16x4*)(lds + HG_QE + (16 * tt + fr) * HG_STR + (32 * a + 4 * fq) * 2);
                const s16x4 hi = *(const LAS s16x4*)(lds + HG_QE + (16 * tt + fr) * HG_STR + (32 * a + 16 + 4 * fq) * 2);
                const bf16x8 qa = __builtin_shufflevector(lo, hi, 0, 1, 2, 3, 4, 5, 6, 7);
                acc = __builtin_amdgcn_mfma_f32_16x16x32_bf16(qa, sp[a], acc, 0, 0, 0);
            }
            o[tt] = acc;
        }
        if (c >= 2) {
#pragma unroll
            for (int tt = 0; tt < 4; ++tt) {
                f32x4 q = o[tt] * o[tt];
#pragma unroll
                for (int sh = 1; sh < 16; sh <<= 1) { q[0] += __shfl_xor(q[0], sh); q[1] += __shfl_xor(q[1], sh); q[2] += __shfl_xor(q[2], sh); q[3] += __shfl_xor(q[3], sh); }
                const int s0 = 64 * c + 16 * tt + 4 * fq - 128;
                if (fr == 0) *(f32x4*)(SSQ + ((size_t)((b * 8 + h) * 8 + w)) * SEQ + s0) = q;
#pragma unroll
                for (int i = 0; i < 4; ++i)
                    OA[((size_t)b * SEQ + s0 + i) * DM + h * 128 + 16 * w + fr] = (bf16_t)(pk2(o[tt][i] * gv, 0.f) & 0xffffu);
            }
        }
    }
#undef HG_LOAD
    __syncthreads();
}

constexpr int AT_SLOT = 65536, AT_VOFF = 32768;
constexpr int AT_X = 0;
__device__ __forceinline__ int crow(int r, int hi) { return (r & 3) + 8 * (r >> 2) + 4 * hi; }
typedef __bf16 bf16x2_t __attribute__((ext_vector_type(2)));
__device__ __forceinline__ unsigned cvtpk_s(float lo, float hi) { f32x2v v = {lo, hi}; bf16x2_t bb = __builtin_convertvector(v, bf16x2_t); return __builtin_bit_cast(unsigned, bb); }
__device__ __forceinline__ float max3f(float a, float b, float c) { return fmaxf(fmaxf(a, b), c); }
constexpr float AT_THR = 8.0f;

__device__ __forceinline__ void attn_unit(ldsp lds, const bf16_t* AQ, const bf16_t* AK, const bf16_t* AV, bf16_t* OB, const float* gB, float lam, int b, int h, int qblk) {
    const int tid = threadIdx.x, lane = tid & 63, w = __builtin_amdgcn_readfirstlane(tid >> 6), comp = w >> 2, qsub = w & 3, r = lane & 31, hi = lane >> 5;
    const int L0 = qblk * 128;
    const size_t rowb = (size_t)(b * 8 + h) * LP;
    const int qL = L0 + 32 * qsub + r;
    int gk[4], gv[4];
    {
        const int l4 = lane >> 4, p16 = lane & 15;
#pragma unroll
        for (int i = 0; i < 4; ++i) { const int row = 16 * w + 4 * i + l4;
            gk[i] = row * 128 + ((p16 ^ (row & 15)) << 3);
            gv[i] = row * 128 + ((p16 ^ ((row & 3) << 2)) << 3); }
    }
#define AT_DMA(j) do { const bf16_t* kb_ = AK + (rowb + 128 * (j)) * 128; const bf16_t* vb_ = AV + (rowb + 128 * (j)) * 128; const int so_ = ((j) & 1) * AT_SLOT + 4 * w * 1024; \
        _Pragma("unroll") for (int i_ = 0; i_ < 4; ++i_) { \
            __builtin_amdgcn_global_load_lds((const unsigned*)(kb_ + gk[i_]), (LAS unsigned*)(lds + so_ + i_ * 1024), 16, 0, 0); \
            __builtin_amdgcn_global_load_lds((const unsigned*)(vb_ + gv[i_]), (LAS unsigned*)(lds + so_ + AT_VOFF + i_ * 1024), 16, 0, 0); } } while (0)
    LBAR();
    if (w >= 6) AT_DMA(0);
    AT_DMA(1);
    bf16x8 qf[4];
    {
        const bf16_t* qp = AQ + (rowb + qL) * 128 + comp * 64 + 8 * hi;
#pragma unroll
        for (int ks = 0; ks < 4; ++ks) qf[ks] = *(const bf16x8*)(qp + 16 * ks);
    }
    f32x16 o[4];
#pragma unroll
    for (int t4 = 0; t4 < 4; ++t4)
#pragma unroll
        for (int i = 0; i < 16; ++i) o[t4][i] = 0.f;
    float mhat = 0.f, lrun = 0.f;
    int kaddr[4], vaddr[4];
    {
        const int q_ = (lane & 15) >> 2, p_ = lane & 3, g1 = (lane >> 4) & 1;
#pragma unroll
        for (int ks = 0; ks < 4; ++ks) kaddr[ks] = r * 256 + (((comp * 8 + 2 * ks + hi) ^ (r & 15)) << 4);
#pragma unroll
        for (int t4 = 0; t4 < 4; ++t4) vaddr[t4] = AT_VOFF + (4 * hi + q_) * 256 + ((((t4 ^ q_) << 2) + g1 * 2 + (p_ >> 1)) << 4) + (p_ & 1) * 8;
    }
    asm volatile("s_waitcnt vmcnt(0)" ::: "memory");
    LBAR();
    {
        f32x16 s3;
#pragma unroll
        for (int i = 0; i < 16; ++i) s3[i] = 0.f;
#pragma unroll
        for (int ks = 0; ks < 4; ++ks) { const bf16x8 kf = *(const LAS bf16x8*)(lds + kaddr[ks] + 3 * 8192); s3 = __builtin_amdgcn_mfma_f32_32x32x16_bf16(kf, qf[ks], s3, 0, 0, 0); }
#pragma unroll
        for (int i = 0; i < 16; ++i) if (96 + crow(i, hi) < PADN) s3[i] = -1e30f;
        float rm = s3[0];
#pragma unroll
        for (int i = 1; i < 16; ++i) rm = fmaxf(rm, s3[i]);
        rm = fmaxf(rm, __shfl_xor(rm, 32));
        mhat = rm;
        float ls = 0.f;
#pragma unroll
        for (int i = 0; i < 16; ++i) { s3[i] = fexp2(s3[i] - rm); ls += s3[i]; }
        lrun = ls;
        u32x4 p0 = (u32x4){cvtpk_s(s3[0], s3[1]), cvtpk_s(s3[2], s3[3]), cvtpk_s(s3[4], s3[5]), cvtpk_s(s3[6], s3[7])};
        u32x4 p1 = (u32x4){cvtpk_s(s3[8], s3[9]), cvtpk_s(s3[10], s3[11]), cvtpk_s(s3[12], s3[13]), cvtpk_s(s3[14], s3[15])};
        const bf16x8 pa0 = __builtin_bit_cast(bf16x8, p0), pa1 = __builtin_bit_cast(bf16x8, p1);
#pragma unroll
        for (int t4 = 0; t4 < 4; ++t4) {
            const s16x4 lo0 = vtr(lds + vaddr[t4] + 96 * 256), hv0 = vtr(lds + vaddr[t4] + 104 * 256), lo1 = vtr(lds + vaddr[t4] + 112 * 256), hv1 = vtr(lds + vaddr[t4] + 120 * 256);
            const bf16x8 vf0 = __builtin_shufflevector(lo0, hv0, 0, 1, 2, 3, 4, 5, 6, 7), vf1 = __builtin_shufflevector(lo1, hv1, 0, 1, 2, 3, 4, 5, 6, 7);
            o[t4] = __builtin_amdgcn_mfma_f32_32x32x16_bf16(vf0, pa0, o[t4], 0, 0, 0);
            o[t4] = __builtin_amdgcn_mfma_f32_32x32x16_bf16(vf1, pa1, o[t4], 0, 0, 0);
        }
    }
    LBAR();
    auto tile = [&](const int j, auto DIAG) __attribute__((always_inline)) {
        constexpr bool diag = decltype(DIAG)::value;
        if (!diag) AT_DMA(j + 1);
        const ldsp sl = lds + (j & 1) * AT_SLOT;
        {
            f32x16 s[4];
            {
                f32x16 negm;
#pragma unroll
                for (int i = 0; i < 16; ++i) negm[i] = -mhat;
#pragma unroll
                for (int ks = 0; ks < 4; ++ks) {
                    bf16x8 kf[4];
#pragma unroll
                    for (int sb = 0; sb < 4; ++sb) kf[sb] = *(const LAS bf16x8*)(sl + kaddr[ks] + sb * 8192);
#pragma unroll
                    for (int sb = 0; sb < 4; ++sb) s[sb] = __builtin_amdgcn_mfma_f32_32x32x16_bf16(kf[sb], qf[ks], ks == 0 ? negm : s[sb], 0, 0, 0);
                }
            }
            if constexpr (diag) {
#pragma unroll
                for (int sb = 0; sb < 4; ++sb)
#pragma unroll
                    for (int i = 0; i < 16; ++i) { const int key = 128 * j + 32 * sb + crow(i, hi); if (key > qL) s[sb][i] = -1e30f; }
            }
            float ma = max3f(s[0][0], s[0][1], s[0][2]), mb = max3f(s[0][3], s[1][0], s[1][1]);
#pragma unroll
            for (int sb = 0; sb < 4; ++sb)
#pragma unroll
                for (int i = 0; i < 16; i += 4) { ma = max3f(ma, s[sb][i], s[sb][i + 1]); mb = max3f(mb, s[sb][i + 2], s[sb][i + 3]); }
            float rm = fmaxf(ma, mb);
            rm = fmaxf(rm, __shfl_xor(rm, 32));
            if (__any(rm > AT_THR)) {
                const float dl = fmaxf(rm, 0.f);
                mhat += dl;
#pragma unroll
                for (int sb = 0; sb < 4; ++sb)
#pragma unroll
                    for (int i = 0; i < 16; ++i) s[sb][i] -= dl;
                const float f = fexp2(-dl);
                lrun *= f;
#pragma unroll
                for (int t4 = 0; t4 < 4; ++t4)
#pragma unroll
                    for (int i = 0; i < 16; ++i) o[t4][i] *= f;
            }
            float ls0 = 0.f, ls1 = 0.f;
#pragma unroll
            for (int sb = 0; sb < 4; ++sb) {
#pragma unroll
                for (int i = 0; i < 16; i += 2) { s[sb][i] = fexp2(s[sb][i]); s[sb][i + 1] = fexp2(s[sb][i + 1]); ls0 += s[sb][i]; ls1 += s[sb][i + 1]; }
                u32x4 p0 = (u32x4){cvtpk_s(s[sb][0], s[sb][1]), cvtpk_s(s[sb][2], s[sb][3]), cvtpk_s(s[sb][4], s[sb][5]), cvtpk_s(s[sb][6], s[sb][7])};
                u32x4 p1 = (u32x4){cvtpk_s(s[sb][8], s[sb][9]), cvtpk_s(s[sb][10], s[sb][11]), cvtpk_s(s[sb][12], s[sb][13]), cvtpk_s(s[sb][14], s[sb][15])};
                const bf16x8 pa0 = __builtin_bit_cast(bf16x8, p0), pa1 = __builtin_bit_cast(bf16x8, p1);
                bf16x8 vf0[4], vf1[4];
#pragma unroll
                for (int t4 = 0; t4 < 4; ++t4) {
                    const s16x4 lo0 = vtr(sl + vaddr[t4] + (32 * sb) * 256);
                    const s16x4 hv0 = vtr(sl + vaddr[t4] + (32 * sb + 8) * 256);
                    const s16x4 lo1 = vtr(sl + vaddr[t4] + (32 * sb + 16) * 256);
                    const s16x4 hv1 = vtr(sl + vaddr[t4] + (32 * sb + 24) * 256);
                    vf0[t4] = __builtin_shufflevector(lo0, hv0, 0, 1, 2, 3, 4, 5, 6, 7);
                    vf1[t4] = __builtin_shufflevector(lo1, hv1, 0, 1, 2, 3, 4, 5, 6, 7);
                }
#pragma unroll
                for (int t4 = 0; t4 < 4; ++t4) o[t4] = __builtin_amdgcn_mfma_f32_32x32x16_bf16(vf0[t4], pa0, o[t4], 0, 0, 0);
#pragma unroll
                for (int t4 = 0; t4 < 4; ++t4) o[t4] = __builtin_amdgcn_mfma_f32_32x32x16_bf16(vf1[t4], pa1, o[t4], 0, 0, 0);
            }
            lrun += ls0 + ls1;
        }
        asm volatile("s_waitcnt vmcnt(0)" ::: "memory");
        LBAR();
    };
    for (int j = 1; j < qblk; ++j) tile(j, std::false_type{});
    tile(qblk, std::true_type{});
#undef AT_DMA
    lrun += __shfl_xor(lrun, 32);
    const float inv = 1.0f / lrun;
    if (comp == 1) {
#pragma unroll
        for (int t4 = 0; t4 < 4; ++t4)
#pragma unroll
            for (int i = 0; i < 16; ++i) *(LAS float*)(lds + AT_X + ((qsub * 64 + t4 * 16 + i) * 64 + lane) * 4) = o[t4][i] * inv;
    }
    LBAR();
    if (comp == 0) {
        float ss = 0.f;
#pragma unroll
        for (int t4 = 0; t4 < 4; ++t4)
#pragma unroll
            for (int i = 0; i < 16; ++i) { const float x2 = *(const LAS float*)(lds + AT_X + ((qsub * 64 + t4 * 16 + i) * 64 + lane) * 4);
                const float v = o[t4][i] * inv - lam * x2; o[t4][i] = v; ss += v * v; }
        ss += __shfl_xor(ss, 32);
        const float rstd = 0.8f / sqrtf(ss * (1.0f / 128.0f) + 1e-6f);
        bf16_t* op = OB + ((size_t)b * SEQ + (qL - 128)) * DM + h * 128;
#pragma unroll
        for (int t4 = 0; t4 < 4; ++t4)
#pragma unroll
            for (int g4 = 0; g4 < 4; ++g4) {
                const int dv = 32 * t4 + 8 * g4 + 4 * hi;
                const f32x4 gg = *(const f32x4*)(gB + dv);
                const u32x2 pk = (u32x2){pk2(o[t4][4 * g4] * rstd * gg[0], o[t4][4 * g4 + 1] * rstd * gg[1]), pk2(o[t4][4 * g4 + 2] * rstd * gg[2], o[t4][4 * g4 + 3] * rstd * gg[3])};
                *(u32x2*)(op + dv) = pk;
            }
    }
}

__device__ __forceinline__ f32x4 meta_dot(const bf16_t* ua, const bf16_t* wb) {
    f32x4 c0 = (f32x4){0.f, 0.f, 0.f, 0.f}, c1 = c0;
#pragma unroll 4
    for (int ks = 0; ks < 32; ks += 2) {
        const bf16x8 a0 = *(const bf16x8*)(ua + 32 * ks), b0 = *(const bf16x8*)(wb + 32 * ks);
        const bf16x8 a1 = *(const bf16x8*)(ua + 32 * ks + 32), b1 = *(const bf16x8*)(wb + 32 * ks + 32);
        c0 = __builtin_amdgcn_mfma_f32_16x16x32_bf16(a0, b0, c0, 0, 0, 0);
        c1 = __builtin_amdgcn_mfma_f32_16x16x32_bf16(a1, b1, c1, 0, 0, 0);
    }
    return c0 + c1;
}
__device__ __forceinline__ void meta_task(const bf16_t* U, const bf16_t* WIN, bf16_t* P, const float* lb, const float* rope, float* EVG, int task, int lane) {
    const int fr = lane & 15, fq = lane >> 4;
    const bf16_t* ua = U + (size_t)(MREAL + fr) * DM + 8 * fq;
    if (task < 64) {
        const int t = task >> 3, uu = task & 7, ch = 16 * uu + fr;
        const f32x4 cq = meta_dot(ua, WIN + (size_t)(256 * t + 16 * uu + fr) * DM + 8 * fq);
        const f32x4 cf = meta_dot(ua, WIN + (size_t)(256 * t + 128 + 16 * uu + fr) * DM + 8 * fq);
        const float lbv = lb[t * 128 + ch];
        float f[4], bc[4], run = 0.f;
#pragma unroll
        for (int i = 0; i < 4; ++i) { f[i] = lbv + (1.0f - lbv) * sigmoidf_(cf[i]); run += __logf(f[i]); bc[i] = run; }
        const float t16 = __shfl_up(run, 16), t32 = __shfl_up(run, 32), t48 = __shfl_up(run, 48);
        const float pre = (fq >= 1 ? t16 : 0.f) + (fq >= 2 ? t32 : 0.f) + (fq >= 3 ? t48 : 0.f);
        const float bl = __shfl(pre + run, 48 + fr);
        unsigned short oq[4], ok[4];
#pragma unroll
        for (int i = 0; i < 4; ++i) {
            const float d = fminf(fmaxf(pre + bc[i], -80.f), 80.f);
            const float e1 = fexp2(d * LOG2E), e2 = __builtin_amdgcn_rcpf(e1);
            oq[i] = (unsigned short)(pk2(cq[i] * e1, 0.f) & 0xffffu); ok[i] = (unsigned short)(pk2((1.0f - f[i]) * e2, 0.f) & 0xffffu);
        }
        const float elv = fexp2(bl * LOG2E);
        for (int b = 0; b < NB; ++b) {
#pragma unroll
            for (int i = 0; i < 4; ++i) { const size_t off = ((size_t)(b * 8 + t) * LP + PADN + 4 * fq + i) * 128 + ch; P[off] = oq[i]; P[PSTRIDE + off] = ok[i]; }
            if (fq == 0) { float* ev = EVG + ((size_t)((b * 8 + t) * 66 + 1)) * 384 + ch; ev[0] = 1.0f; ev[128] = elv; ev[256] = fexp2(fmaxf(bl, -100.f) * LOG2E); }
        }
        return;
    }
    const int n0 = 2048 + 16 * (task - 64), seg = 2 + ((n0 - 2048) >> 10), col = ((n0 - 2048) & 1023) + fr;
    f32x4 c = meta_dot(ua, WIN + (size_t)(n0 + fr) * DM + 8 * fq);
    if ((seg == 3 || seg == 4) && ((n0 & 63) == 0)) {
#pragma unroll
        for (int i = 0; i < 4; ++i) {
            const float p = __shfl_xor(c[i], 8);
            const float* rt = rope + (size_t)(4 * fq + i) * 16;
            const float cs = rt[fr & 7], sn = rt[8 + (fr & 7)];
            c[i] = (fr < 8) ? c[i] * cs - p * sn : c[i] * cs + p * sn;
        }
    }
    if (seg == 3) c = c * QSCALE;
    bf16_t* base = P + (size_t)seg * PSTRIDE + (col & 127);
#pragma unroll
    for (int i = 0; i < 4; ++i) { const unsigned short ob = (unsigned short)(pk2(c[i], 0.f) & 0xffffu);
        for (int b = 0; b < NB; ++b) base[((size_t)(b * 8 + (col >> 7)) * LP + PADN + 4 * fq + i) * 128] = ob; }
}

constexpr size_t WS_XBAR = 896 * 1024;
#define XB_TMO      128
#define XB_XCNT(j)  (256  + 64 * (j))
#define XB_XSUB(j)  (1280 + 64 * (j))
#define XB_XGEN(j)  (2304 + 64 * (j))
#define XB_TOP      3328
#define XB_TOPGEN   3392
#define XCD_BAR_WORDS 3456
#define XB_SPIN_CAP (1u << 18)

__device__ __forceinline__ unsigned xb_ld(unsigned* p)              { return __hip_atomic_load(p, __ATOMIC_RELAXED, __HIP_MEMORY_SCOPE_AGENT); }
__device__ __forceinline__ unsigned xb_add(unsigned* p, unsigned v) { return __hip_atomic_fetch_add(p, v, __ATOMIC_RELAXED, __HIP_MEMORY_SCOPE_AGENT); }
__device__ __forceinline__ unsigned xb_xcc_id() { return (unsigned)__builtin_amdgcn_s_getreg((3 << 11) | 20) & 0xFu; }
#define XB_SPIN(cond, bar) do { unsigned _sp = 0; while (cond) { __builtin_amdgcn_s_sleep(1); \
    if ((++_sp & 255u) == 0u) { if (xb_ld(&(bar)[XB_TMO])) break; if (_sp > XB_SPIN_CAP) { atomicAdd(&(bar)[XB_TMO], 1u); break; } } } } while (0)

struct XcdBarrier {
    unsigned* bar; unsigned x;
    volatile LAS unsigned* st;
};

__device__ __forceinline__ XcdBarrier xcd_barrier_post(unsigned* bar, volatile LAS unsigned* st) {
    XcdBarrier b; b.bar = bar; b.x = xb_xcc_id(); b.st = st;
    if (threadIdx.x == 0) (void)xb_add(&bar[XB_XCNT(b.x)], 1u);
    return b;
}
__device__ __forceinline__ void xcd_barrier_complete(unsigned* bar, unsigned x, unsigned& nloc, unsigned& nx) {
    const unsigned G = gridDim.x * gridDim.y * gridDim.z;
    unsigned sum, cnt, mine, sp = 0u;
    for (;;) {
        sum = 0u; cnt = 0u; mine = 0u;
#pragma unroll
        for (unsigned j = 0; j < 16; ++j) { const unsigned c = xb_ld(&bar[XB_XCNT(j)]); sum += c; cnt += (c > 0u) ? 1u : 0u; mine = (j == x) ? c : mine; }
        if (sum == G) break;
        __builtin_amdgcn_s_sleep(1);
        if ((++sp & 255u) == 0u) { if (xb_ld(&bar[XB_TMO])) break; if (sp > XB_SPIN_CAP) { atomicAdd(&bar[XB_TMO], 1u); break; } }
    }
    nloc = mine > 0u ? mine : 1u; nx = cnt > 0u ? cnt : 1u;
}

__device__ __forceinline__ void xcd_barrier(const XcdBarrier& b) {
    asm volatile("s_waitcnt vmcnt(0)" ::: "memory");
    __syncthreads();
    if (threadIdx.x == 0) {
        unsigned* bar = b.bar;
        __builtin_amdgcn_s_waitcnt(0);
        unsigned nloc = b.st[0], nx = b.st[1];
        if (nloc == 0u) { xcd_barrier_complete(bar, b.x, nloc, nx); b.st[0] = nloc; b.st[1] = nx; }
        const unsigned old = xb_add(&bar[XB_XSUB(b.x)], 1u);
        const unsigned gen = old / nloc;
        if (old + 1u == (gen + 1u) * nloc) {
            __builtin_amdgcn_fence(__ATOMIC_RELEASE, "agent");
            asm volatile("s_waitcnt vmcnt(0)" ::: "memory");
            const unsigned og = xb_add(&bar[XB_TOP], 1u);
            const unsigned tg = og / nx;
            if (og + 1u == (tg + 1u) * nx) xb_add(&bar[XB_TOPGEN], 1u);
            else XB_SPIN(xb_ld(&bar[XB_TOPGEN]) == tg, bar);
            __builtin_amdgcn_fence(__ATOMIC_ACQUIRE, "agent");
            xb_add(&bar[XB_XGEN(b.x)], 1u);
            asm volatile("s_waitcnt vmcnt(0)" ::: "memory");
        } else {
            XB_SPIN(xb_ld(&bar[XB_XGEN(b.x)]) == gen, bar);
            __builtin_amdgcn_fence(__ATOMIC_ACQUIRE, "agent");
            asm volatile("s_waitcnt vmcnt(0)" ::: "memory");
        }
    }
    __syncthreads();
}

#ifndef REPMASK
#define REPMASK 0
#endif
#define NREP(k) ((((REPMASK) >> (k)) & 1) + 1)
struct Args { const float* in[12]; float* out; unsigned char* ws; int ph_lo, ph_hi, flags, pad; };
constexpr int NPH = 7;

__global__ void __launch_bounds__(512, 2) mega_fwd(Args args) {
    extern __shared__ __attribute__((aligned(16))) unsigned char lds_raw[];
    ldsp lds = (ldsp)lds_raw;
    const int tid = threadIdx.x, lane = tid & 63, wave = __builtin_amdgcn_readfirstlane(tid >> 6);
    const int G = gridDim.x, bx = blockIdx.x;
    unsigned char* ws = args.ws;
    const float* x = args.in[0]; const float* meta = args.in[1]; const float* norm_g = args.in[2]; const float* w_in = args.in[3];
    const float* lb_logits = args.in[4]; const float* hg_g = args.in[5]; const float* da_lambda = args.in[6]; const float* da_g = args.in[7];
    const float* w_a = args.in[8]; const float* w_b = args.in[9]; const float* w_o = args.in[10]; const float* final_g = args.in[11];
    unsigned* ctl = (unsigned*)(ws + WS_CTL);
    float* lamp = (float*)(ws + WS_CTL + 1024);
    float* lbt = (float*)(ws + WS_LB);
    float* rope = (float*)(ws + WS_ROPE);
    float* rmsx = (float*)(ws + 512 * 1024);
    float* ginv = (float*)(ws + 768 * 1024);
    bf16_t* WIN = (bf16_t*)(ws + WS_WIN); bf16_t* WA = (bf16_t*)(ws + WS_WA); bf16_t* WB = (bf16_t*)(ws + WS_WB); bf16_t* WO = (bf16_t*)(ws + WS_WO);
    bf16_t* U = (bf16_t*)(ws + WS_U);
    float* EVG = (float*)(ws + WS_EV);
    float* SSQ = (float*)(ws + WS_SSQ);
    bf16_t* P = (bf16_t*)(ws + WS_P);
    bf16_t* OAB = (bf16_t*)args.out;
    const int lo = args.ph_lo, hi = args.ph_hi;
    cg::grid_group grid = cg::this_grid();
    volatile LAS unsigned* bst = (volatile LAS unsigned*)(lds + 131072 + 16);
    if (tid == 0) { bst[0] = 0u; bst[1] = 0u; }
    __syncthreads();
    const XcdBarrier xbar = xcd_barrier_post((unsigned*)(ws + WS_XBAR), bst);
    if (args.flags == 0x7fffffff) grid.sync();
#define IN(k) (lo <= (k) && (k) < hi)
#define SEAM(k) do { if (IN(k) && IN((k) + 1)) xcd_barrier(xbar); } while (0)

    if (IN(0)) for (int rep_ = 0; rep_ < NREP(0); ++rep_) {
        if (rep_) grid.sync();
        const int gw = bx * 8 + wave, NGW = G * 8;
        const int gt = bx * 512 + tid, NGT = G * 512;
        if (bx == 0 && tid < 8) ctl[16 * tid] = 0u;
        if (bx == 0 && tid == 0) {
            float s1 = 0.f, s2 = 0.f;
            for (int i = 0; i < 64; ++i) { s1 += da_lambda[i] * da_lambda[64 + i]; s2 += da_lambda[128 + i] * da_lambda[192 + i]; }
            *lamp = expf(s1) - expf(s2) + 0.2f;
        }
        for (int i = gt; i < 1024; i += NGT) { const float l0 = lb_logits[i], l1 = lb_logits[1024 + i]; lbt[i] = 1.0f / (1.0f + expf(l1 - l0)); ginv[i] = 1.0f / norm_g[i]; }
        for (int i = gt; i < 4112 * 8; i += NGT) { const int pos = i >> 3, j = i & 7;
            const float invf = powf(500000.0f, -(float)j * 0.125f); const float ang = (float)pos * invf;
            float sn, cs; sincos_d(ang, sn, cs); rope[pos * 16 + j] = cs; rope[pos * 16 + 8 + j] = sn; }
        LAS float* scr = (LAS float*)(lds + wave * 16384);
        constexpr int I_IN = 16 * 320, I_SQ = 16 * 32;
        for (int it = gw; it < I_IN + 3 * I_SQ; it += NGW) {
            if (it < I_IN) { const int kb = it / 320, nb = it % 320, n0 = nb * 32, sg = n0 >> 10;
                const int wi = n0 & 1023;
                const int drow = sg == 0 ? ((wi >> 7) * 256 + (wi & 127)) : sg == 1 ? ((wi >> 7) * 256 + 128 + (wi & 127))
                               : (int)((0x9875436210ULL >> (4 * sg)) & 0xFULL) * 1024 + wi;
                p0_transpose_item(w_in, 1024, 10240, WIN, drow, scr, kb * 64, n0, lane); }
            else { const int r = it - I_IN, m = r / I_SQ, q = r % I_SQ, kb = q / 32, nb = q % 32;
                const float* W = m == 0 ? w_a : (m == 1 ? w_b : w_o); bf16_t* WT = m == 0 ? WA : (m == 1 ? WB : WO);
                p0_transpose_item(W, 1024, 1024, WT, nb * 32, scr, kb * 64, nb * 32, lane); }
        }
        for (int m = gw; m < MU; m += NGW) {
            const float* xr = m < MREAL ? x + (size_t)m * DM : (m < MREAL + 16 ? meta + (size_t)(m - MREAL) * DM : nullptr);
            u_row(xr, norm_g, U + (size_t)m * DM, lane, m < MREAL ? rmsx + m : nullptr);
        }
        for (int i = gt; i < 6 * 64 * PADN * 16; i += NGT) { const int run = i / (PADN * 16), q = i % (PADN * 16), a6 = run >> 6, bh = run & 63;
            *(u32x4*)(P + (size_t)a6 * PSTRIDE + (size_t)bh * LP * 128 + (size_t)q * 8) = (u32x4){0u, 0u, 0u, 0u}; }
        __syncthreads();
    }
    SEAM(0);
    if (IN(1)) for (int rep_ = 0; rep_ < NREP(1); ++rep_) {
        if (rep_) grid.sync();
        { const int gw = bx * 8 + wave; if (gw < 320) meta_task(U, WIN, P, lbt, rope, EVG, gw, lane); }
        pg8::Gemm g{U, WIN, MREAL, 6144, 1024}; pg8::StaticOrder S; S.init(MREAL, 6144, G, bx);
        pg8::EpiProj E{P, lbt, rope, EVG};
        pg8::gemm_phase<pg8::EpiProj, pg8::StaticOrder, true, true>(lds, g, S, E);
        __syncthreads();
    }
    SEAM(1);
    if (IN(2)) {
        if (bx < 64 && !(args.flags & 1)) {
            hgrn_seq(lds, P, P + PSTRIDE, P + 2 * PSTRIDE, EVG, OAB, SSQ, hg_g, bx >> 3, bx & 7);
            float* RST = SSQ + (size_t)64 * 8 * SEQ;
            for (int sI = tid; sI < SEQ; sI += 512) { float tot = 0.f;
#pragma unroll
                for (int ww = 0; ww < 8; ++ww) tot += SSQ[((size_t)(bx * 8 + ww)) * SEQ + sI];
                RST[(size_t)bx * SEQ + sI] = __builtin_amdgcn_rsqf(tot * (1.0f / 128.0f) + 1e-6f); }
        }
        const float lam = *lamp;
        LAS unsigned* qslot = (LAS unsigned*)(lds + 131072);
        const int xq = bx & 7;
        if (!(args.flags & 2)) for (;;) {
            __syncthreads();
            if (tid == 0) *qslot = atomicAdd(ctl + 16 * xq, 1u);
            __syncthreads();
            const unsigned idx = *qslot;
            if (idx >= 256u) break;
            const int pass = (int)(idx >> 7), k = (int)(idx & 127u), bhl = k >> 4, qi = k & 15;
            const int qblk = (pass == 0 ? 32 : 16) - qi, bh = 8 * bhl + xq;
            attn_unit(lds, P + 3 * PSTRIDE, P + 4 * PSTRIDE, P + 5 * PSTRIDE, OAB + P3STRIDE, da_g, lam, bh >> 3, bh & 7, qblk);
        }
        __syncthreads();
    }
    SEAM(2);
    if (IN(3)) for (int rep_ = 0; rep_ < NREP(3); ++rep_) {
        if (rep_) grid.sync();
        pg8::Gemm g{U, WIN + (size_t)6144 * 1024, MREAL, 4096, 1024}; pg8::StaticOrder S; S.init(MREAL, 4096, G, bx);
        pg8::EpiGate E{P, OAB, SSQ + (size_t)64 * 8 * SEQ};
        pg8::gemm_phase<pg8::EpiGate, pg8::StaticOrder, true, true>(lds, g, S, E);
        __syncthreads();
    }
    SEAM(3);
    if (IN(4)) for (int rep_ = 0; rep_ < NREP(4); ++rep_) {
        if (rep_) grid.sync();
        bf16_t* Mx = P + 4 * P3STRIDE;
        { pg8::Gemm g{P, WA, MREAL, 1024, 1024}; pg8::StaticOrder S; S.init(MREAL, 1024, G, bx);
          pg8::EpiMix<0> E{Mx, P + 2 * P3STRIDE};
          pg8::gemm_phase<pg8::EpiMix<0>, pg8::StaticOrder, true, true>(lds, g, S, E); }
        __syncthreads();
        { pg8::Gemm g{P + P3STRIDE, WB, MREAL, 1024, 1024}; pg8::StaticOrder S; S.init(MREAL, 1024, G, bx);
          pg8::EpiMix<1> E{Mx, P + 3 * P3STRIDE};
          pg8::gemm_phase<pg8::EpiMix<1>, pg8::StaticOrder, true, true>(lds, g, S, E); }
        __syncthreads();
    }
    SEAM(4);
    if (IN(5)) for (int rep_ = 0; rep_ < NREP(5); ++rep_) {
        if (rep_) grid.sync();
        pg8::Gemm g{P + 4 * P3STRIDE, WO, MREAL, 1024, 1024}; pg8::StaticOrder S; S.init(MREAL, 1024, G, bx);
        pg8::EpiOut E{U, rmsx, ginv, P + 5 * P3STRIDE};
        pg8::gemm_phase<pg8::EpiOut, pg8::StaticOrder, true, true>(lds, g, S, E);
        __syncthreads();
    }
    SEAM(5);
    if (IN(6)) {
        const int gw = bx * 8 + wave, NGW = G * 8;
        const bf16_t* H16 = P + 5 * P3STRIDE;
        f32x4 g0[2], g1[2];
#pragma unroll
        for (int j = 0; j < 2; ++j) { g0[j] = *(const f32x4*)(final_g + j * 512 + lane * 8); g1[j] = *(const f32x4*)(final_g + j * 512 + lane * 8 + 4); }
        for (int m = gw; m < MREAL; m += NGW) {
            const bf16_t* hrow = H16 + (size_t)m * DM; float* orow = args.out + (size_t)m * DM;
            float v[2][8]; float s = 0.f;
#pragma unroll
            for (int j = 0; j < 2; ++j) { const u32x4 hv = *(const u32x4*)(hrow + j * 512 + lane * 8);
                v[j][0] = bflo(hv.x); v[j][1] = bfhi(hv.x); v[j][2] = bflo(hv.y); v[j][3] = bfhi(hv.y); v[j][4] = bflo(hv.z); v[j][5] = bfhi(hv.z); v[j][6] = bflo(hv.w); v[j][7] = bfhi(hv.w);
#pragma unroll
                for (int i = 0; i < 8; ++i) s += v[j][i] * v[j][i]; }
            const float rstd = 1.0f / sqrtf(wave_sum(s) * (1.0f / DM) + 1e-6f);
#pragma unroll
            for (int j = 0; j < 2; ++j) {
                *(f32x4*)(orow + j * 512 + lane * 8) = (f32x4){v[j][0] * rstd * g0[j][0], v[j][1] * rstd * g0[j][1], v[j][2] * rstd * g0[j][2], v[j][3] * rstd * g0[j][3]};
                *(f32x4*)(orow + j * 512 + lane * 8 + 4) = (f32x4){v[j][4] * rstd * g1[j][0], v[j][5] * rstd * g1[j][1], v[j][6] * rstd * g1[j][2], v[j][7] * rstd * g1[j][3]};
            }
        }
    }
#undef IN
#undef SEAM
}

#ifndef MK_LAUNCHES
#define MK_LAUNCHES 1
#endif

extern "C" void kernel_launch(void* const* d_in, const int* in_sizes, int n_in, void* d_out, int out_size, void* d_ws, size_t ws_size, hipStream_t stream) {
    static int grid = 0;
    if (grid == 0) {
        if (n_in != 12 || out_size != MREAL * DM || ws_size < WS_NEED) { fprintf(stderr, "kernel_launch: unexpected shapes (n_in %d out %d ws %zu need %zu)\n", n_in, out_size, ws_size, (size_t)WS_NEED); grid = -1; return; }
        int dev = 0, cus = 0, per_cu = 0;
        hipGetDevice(&dev); hipDeviceGetAttribute(&cus, hipDeviceAttributeMultiprocessorCount, dev);
        if (hipFuncSetAttribute((const void*)mega_fwd, hipFuncAttributeMaxDynamicSharedMemorySize, LDS_BYTES) != hipSuccess) { fprintf(stderr, "kernel_launch: hipFuncSetAttribute failed\n"); grid = -1; return; }
        hipOccupancyMaxActiveBlocksPerMultiprocessor(&per_cu, (const void*)mega_fwd, 512, LDS_BYTES);
        (void)hipGetLastError();
        if (per_cu < 1) per_cu = 1;
        grid = cus;
        fprintf(stderr, "kernel_launch: cus %d per_cu %d grid %d\n", cus, per_cu, grid);
    }
    if (grid < 0) return;
    Args a{};
    for (int i = 0; i < 12; ++i) a.in[i] = (const float*)d_in[i];
    a.out = (float*)d_out; a.ws = (unsigned char*)d_ws;
#if MK_LAUNCHES == 1
    void* kargs[] = {&a};
#ifndef MK_PROBE
#define MK_PROBE 0
#endif
#if MK_PROBE == 0
    a.ph_lo = 0; a.ph_hi = NPH;
    (void)hipMemsetAsync((char*)d_ws + WS_XBAR, 0, 16384, stream);
    hipError_t e = hipLaunchCooperativeKernel((const void*)mega_fwd, dim3(grid), dim3(512), kargs, LDS_BYTES, stream);
    if (e != hipSuccess) fprintf(stderr, "kernel_launch: cooperative launch failed: %s (grid %d)\n", hipGetErrorString(e), grid);
#else
    a.ph_lo = 0; a.ph_hi = MK_PROBE_PH + 1; a.flags = 0;
    (void)hipMemsetAsync((char*)d_ws + WS_XBAR, 0, 16384, stream);
    (void)hipLaunchCooperativeKernel((const void*)mega_fwd, dim3(grid), dim3(512), kargs, LDS_BYTES, stream);
    (void)hipMemsetAsync(d_ws, 0, 512, stream);
    (void)hipMemsetAsync((char*)d_ws + WS_XBAR, 0, 16384, stream);
    a.ph_lo = MK_PROBE_PH; a.ph_hi = MK_PROBE_PH + 1; a.flags = MK_PROBE_FLAGS;
    (void)hipLaunchCooperativeKernel((const void*)mega_fwd, dim3(grid), dim3(512), kargs, LDS_BYTES, stream);
    a.ph_lo = MK_PROBE_PH + 1; a.ph_hi = NPH; a.flags = 0;
    (void)hipMemsetAsync((char*)d_ws + WS_XBAR, 0, 16384, stream);
    (void)hipLaunchCooperativeKernel((const void*)mega_fwd, dim3(grid), dim3(512), kargs, LDS_BYTES, stream);
#endif
#else
    for (int p = 0; p < NPH; ++p) { a.ph_lo = p; a.ph_hi = p + 1; hipLaunchKernelGGL(mega_fwd, dim3(grid), dim3(512), LDS_BYTES, stream, a); }
#endif
}
```
